# Optimizing an MI355X kernel written in HIP

```python
import jax, jax.numpy as jnp
from jax import lax
import numpy as np

D_MODEL = 2048
BATCH = 16
SEQ = 2048
DEPTH = 2

GRID_W = 64
MLSTM_HEADS = 8
MLSTM_HD = 128
MLSTM_W = MLSTM_HEADS * MLSTM_HD
MLSTM_CHUNK = 128
ATTN_HEADS = 8
ATTN_KV_HEADS = 2
ATTN_HD = 128
ATTN_GROUP = ATTN_HEADS // ATTN_KV_HEADS
ATTN_Q_W = ATTN_HEADS * ATTN_HD
ATTN_KV_W = ATTN_KV_HEADS * ATTN_HD
Q_BLOCK = 128
ROPE_THETA = 10000.0
ROPE_PAIRS = ATTN_HD // 4
SPLIT_SIZES = (MLSTM_W, MLSTM_W, MLSTM_W, MLSTM_W, 4 * MLSTM_HEADS,
               ATTN_Q_W, ATTN_KV_W, ATTN_KV_W, D_MODEL, D_MODEL)
IN_W = sum(SPLIT_SIZES)
N_GROUPS = 4
EXPERTS_PER_GROUP = 8
N_EXPERTS = N_GROUPS * EXPERTS_PER_GROUP
TOP_K = 2
D_FF = 512
EXPERT_BLOCK = 128
PLE_DIM = 256
EPS = 1e-6

kernel_name = "hybrid_mlstm_axial_gqa_hmoe_encoder"


def rmsnorm(x, g):
    xf = x.astype(jnp.float32)
    y = xf * lax.rsqrt(jnp.mean(xf * xf, axis=-1, keepdims=True) + EPS)
    return (y * g.astype(jnp.float32)).astype(x.dtype)


def mlstm_chunkwise(q, k, v, logi, logf):
    B, H, S, dk = q.shape
    dv = v.shape[-1]
    nc = S // MLSTM_CHUNK
    L = MLSTM_CHUNK
    to_c = lambda t: jnp.moveaxis(t.reshape(B, H, nc, L, *t.shape[3:]), 2, 0)
    qc, kc, vc, lic = to_c(q), to_c(k), to_c(v), to_c(logi)
    bc = jnp.cumsum(to_c(logf), axis=-1)
    tril = jnp.tril(jnp.ones((L, L), dtype=bool))

    def step(carry, xs):
        C, n, m = carry
        qi, ki, vi, li, bi = xs
        dmat = bi[..., :, None] - bi[..., None, :] + li[..., None, :]
        dmat = jnp.where(tril, dmat, -jnp.inf)
        inter = bi + m[..., None]
        m_t = jnp.maximum(jnp.max(dmat, axis=-1), inter)
        s = jnp.einsum("bhtd,bhsd->bhts", qi, ki) * jnp.exp(dmat - m_t[..., None])
        g = jnp.exp(inter - m_t)
        num = jnp.einsum("bhts,bhse->bhte", s, vi) + g[..., None] * jnp.einsum("bhtd,bhde->bhte", qi, C)
        den = jnp.sum(s, axis=-1) + g * jnp.einsum("bhtd,bhd->bht", qi, n)
        h = num / jnp.maximum(jnp.abs(den), jnp.exp(-m_t))[..., None]
        b_last = bi[..., -1]
        a = b_last[..., None] - bi + li
        m_new = jnp.maximum(b_last + m, jnp.max(a, axis=-1))
        decay = jnp.exp(b_last + m - m_new)
        wk = jnp.exp(a - m_new[..., None])
        C_new = decay[..., None, None] * C + jnp.einsum("bhs,bhsd,bhse->bhde", wk, ki, vi)
        n_new = decay[..., None] * n + jnp.einsum("bhs,bhsd->bhd", wk, ki)
        return (C_new, n_new, m_new), h

    init = (jnp.zeros((B, H, dk, dv), jnp.float32), jnp.zeros((B, H, dk), jnp.float32),
            jnp.zeros((B, H), jnp.float32))
    _, hs = lax.scan(step, init, (qc, kc, vc, lic, bc))
    return jnp.moveaxis(hs, 0, 2).reshape(B, H, S, dv)


def bidir_mlstm(q, k, v, o, gates_pre, gate_b, norm_g):
    B, S, _ = q.shape
    heads = lambda t: t.reshape(B, S, MLSTM_HEADS, MLSTM_HD).transpose(0, 2, 1, 3).astype(jnp.float32)
    qh = heads(q) * (MLSTM_HD ** -0.5)
    kh, vh = heads(k), heads(v)
    g = (gates_pre.astype(jnp.float32) + gate_b.astype(jnp.float32))
    g = g.reshape(B, S, 4, MLSTM_HEADS).transpose(2, 0, 3, 1)
    i_fw, i_bw, f_fw, f_bw = g[0], g[1], g[2], g[3]
    h_fw = mlstm_chunkwise(qh, kh, vh, i_fw, jax.nn.log_sigmoid(f_fw))
    flip = lambda t: jnp.flip(t, axis=2)
    h_bw = flip(mlstm_chunkwise(flip(qh), flip(kh), flip(vh), flip(i_bw),
                                jax.nn.log_sigmoid(flip(f_bw))))
    hsum = (h_fw + h_bw).transpose(0, 2, 1, 3)
    hn = rmsnorm(hsum, norm_g.reshape(MLSTM_HEADS, MLSTM_HD)).reshape(B, S, MLSTM_W)
    return hn.astype(q.dtype) * jax.nn.sigmoid(o)


def axial_rope(t, ang_row, ang_col):
    def rot(u, ang):
        a, b = jnp.split(u, 2, axis=-1)
        c = jnp.cos(ang)[None, :, None, :]
        s = jnp.sin(ang)[None, :, None, :]
        return jnp.concatenate([a * c - b * s, b * c + a * s], axis=-1)
    half = ATTN_HD // 2
    return jnp.concatenate([rot(t[..., :half], ang_row), rot(t[..., half:], ang_col)], axis=-1)


def grid_attention(q, k, v, q_g, k_g, ang_row, ang_col):
    B, S, _ = q.shape
    nb = S // Q_BLOCK
    qh = q.reshape(B, S, ATTN_HEADS, ATTN_HD)
    kh = k.reshape(B, S, ATTN_KV_HEADS, ATTN_HD)
    vh = v.reshape(B, S, ATTN_KV_HEADS, ATTN_HD)
    qh = axial_rope(rmsnorm(qh, q_g).astype(jnp.float32), ang_row, ang_col).astype(q.dtype)
    kh = axial_rope(rmsnorm(kh, k_g).astype(jnp.float32), ang_row, ang_col).astype(k.dtype)
    qb = qh.reshape(B, nb, Q_BLOCK, ATTN_KV_HEADS, ATTN_GROUP, ATTN_HD).transpose(1, 0, 3, 4, 2, 5)
    kt = kh.transpose(0, 2, 1, 3)
    vt = vh.transpose(0, 2, 1, 3)
    scale = ATTN_HD ** -0.5

    def block(qi):
        s = jnp.einsum("bhgqd,bhkd->bhgqk", qi, kt).astype(jnp.float32) * scale
        pr = jax.nn.softmax(s, axis=-1).astype(vt.dtype)
        return jnp.einsum("bhgqk,bhkd->bhgqd", pr, vt)

    o = lax.map(block, qb)
    return o.transpose(1, 0, 4, 2, 3, 5).reshape(B, S, ATTN_Q_W)


def hier_moe(h, w_rg, b_rg, w_re, b_re, w_g, w_u, w_d):
    B, S, D = h.shape
    T = B * S
    hf = h.reshape(T, D)
    gprob = jax.nn.softmax((hf @ w_rg).astype(jnp.float32) + b_rg.astype(jnp.float32), axis=-1)
    gp, gi = lax.top_k(gprob, 1)
    elog = ((hf @ w_re).astype(jnp.float32) + b_re.astype(jnp.float32)).reshape(T, N_GROUPS, EXPERTS_PER_GROUP)
    elog_g = jnp.take_along_axis(elog, gi[:, :, None], axis=1)[:, 0]
    ev, ei = lax.top_k(elog_g, TOP_K)
    wts = jax.nn.softmax(ev, axis=-1) * gp
    eid = (gi * EXPERTS_PER_GROUP + ei).reshape(-1).astype(jnp.int32)
    wflat = wts.reshape(-1)
    n_assign = T * TOP_K
    slot_ids = jnp.arange(n_assign, dtype=jnp.int32)
    tok = slot_ids // TOP_K
    order = jnp.argsort(eid)
    se, st, sw = eid[order], tok[order], wflat[order]
    counts = jnp.bincount(eid, length=N_EXPERTS).astype(jnp.int32)
    padded = ((counts + EXPERT_BLOCK - 1) // EXPERT_BLOCK) * EXPERT_BLOCK
    pad_end = jnp.cumsum(padded)
    pad_start = pad_end - padded
    start = jnp.cumsum(counts) - counts
    dest = pad_start[se] + slot_ids - start[se]
    P = n_assign + N_EXPERTS * EXPERT_BLOCK
    nblk = P // EXPERT_BLOCK
    slot_tok = jnp.full((P,), T, dtype=jnp.int32).at[dest].set(st)
    slot_w = jnp.zeros((P,), jnp.float32).at[dest].set(sw)
    blk_e = jnp.minimum(jnp.searchsorted(pad_end, jnp.arange(nblk, dtype=jnp.int32) * EXPERT_BLOCK,
                                         side="right"), N_EXPERTS - 1)
    x_pad = jnp.concatenate([hf, jnp.zeros((1, D), hf.dtype)], axis=0)

    def run(args):
        e, tk, wt = args
        xb = x_pad[tk]
        y = (jax.nn.silu(xb @ w_g[e]) * (xb @ w_u[e])) @ w_d[e]
        return y * wt[:, None].astype(y.dtype)

    ys = lax.map(run, (blk_e, slot_tok.reshape(nblk, EXPERT_BLOCK), slot_w.reshape(nblk, EXPERT_BLOCK)))
    out = jnp.zeros((T + 1, D), h.dtype).at[slot_tok].add(ys.reshape(P, D))
    return out[:T].reshape(B, S, D)


def setup_inputs(seed: int = 0) -> dict:
    key = jax.random.key(seed)
    ks = jax.random.split(key, 24)
    nrm = lambda k, shape, fan_in: jax.random.normal(k, shape, jnp.float32) * (fan_in ** -0.5)
    gain = lambda k, shape: 1.0 + 0.02 * jax.random.normal(k, shape, jnp.float32)
    i_bias = 0.1 * jax.random.normal(ks[5], (DEPTH, 2 * MLSTM_HEADS), jnp.float32)
    f_base = jnp.tile(jnp.linspace(3.0, 6.0, MLSTM_HEADS, dtype=jnp.float32), 2)
    f_bias = f_base[None, :] + 0.1 * jax.random.normal(ks[6], (DEPTH, 2 * MLSTM_HEADS), jnp.float32)
    return {
        "x": jax.random.normal(ks[0], (BATCH, SEQ, D_MODEL), jnp.float32),
        "p": jax.random.normal(ks[1], (DEPTH, BATCH, SEQ, PLE_DIM), jnp.float32),
        "norm1_g": gain(ks[2], (DEPTH, D_MODEL)),
        "w_in": nrm(ks[3], (DEPTH, D_MODEL, IN_W), D_MODEL),
        "mlstm_gate_b": jnp.concatenate([i_bias, f_bias], axis=-1),
        "mlstm_norm_g": gain(ks[4], (DEPTH, MLSTM_W)),
        "q_norm_g": gain(ks[7], (DEPTH, ATTN_HD)),
        "k_norm_g": gain(ks[8], (DEPTH, ATTN_HD)),
        "w_branch_m": nrm(ks[9], (DEPTH, MLSTM_W, D_MODEL), MLSTM_W),
        "w_branch_a": nrm(ks[10], (DEPTH, ATTN_Q_W, D_MODEL), ATTN_Q_W),
        "w_out": nrm(ks[11], (DEPTH, D_MODEL, D_MODEL), D_MODEL),
        "norm2_g": gain(ks[12], (DEPTH, D_MODEL)),
        "w_router_group": nrm(ks[13], (DEPTH, D_MODEL, N_GROUPS), D_MODEL),
        "b_router_group": 0.01 * jax.random.normal(ks[14], (DEPTH, N_GROUPS), jnp.float32),
        "w_router_expert": nrm(ks[15], (DEPTH, D_MODEL, N_EXPERTS), D_MODEL),
        "b_router_expert": 0.01 * jax.random.normal(ks[16], (DEPTH, N_EXPERTS), jnp.float32),
        "w_exp_gate": nrm(ks[17], (DEPTH, N_EXPERTS, D_MODEL, D_FF), D_MODEL),
        "w_exp_up": nrm(ks[18], (DEPTH, N_EXPERTS, D_MODEL, D_FF), D_MODEL),
        "w_exp_down": nrm(ks[19], (DEPTH, N_EXPERTS, D_FF, D_MODEL), D_FF),
        "ple_norm_g": gain(ks[20], (DEPTH, D_MODEL)),
        "w_ple_gate": nrm(ks[21], (DEPTH, D_MODEL, D_MODEL), D_MODEL),
        "w_ple_proj": nrm(ks[22], (DEPTH, PLE_DIM, D_MODEL), PLE_DIM),
        "final_norm_g": gain(ks[23], (D_MODEL,)),
    }


def reference(x, p, norm1_g, w_in, mlstm_gate_b, mlstm_norm_g, q_norm_g, k_norm_g,
              w_branch_m, w_branch_a, w_out, norm2_g, w_router_group, b_router_group,
              w_router_expert, b_router_expert, w_exp_gate, w_exp_up, w_exp_down,
              ple_norm_g, w_ple_gate, w_ple_proj, final_norm_g):
    S = x.shape[1]
    ROWS = S // GRID_W
    row = jnp.repeat(jnp.arange(ROWS, dtype=jnp.float32), GRID_W)
    col = jnp.tile(jnp.arange(GRID_W, dtype=jnp.float32), ROWS)
    inv_freq = ROPE_THETA ** (-jnp.arange(ROPE_PAIRS, dtype=jnp.float32) / ROPE_PAIRS)
    ang_row = row[:, None] * inv_freq[None, :]
    ang_col = col[:, None] * inv_freq[None, :]
    split_idx = np.cumsum(SPLIT_SIZES)[:-1].tolist()

    for i in range(DEPTH):
        h = rmsnorm(x, norm1_g[i])
        z = h @ w_in[i]
        q_m, k_m, v_m, o_m, g_m, q_a, k_a, v_a, gate_m, gate_a = jnp.split(z, split_idx, axis=-1)
        y_m = bidir_mlstm(q_m, k_m, v_m, o_m, g_m, mlstm_gate_b[i], mlstm_norm_g[i])
        y_a = grid_attention(q_a, k_a, v_a, q_norm_g[i], k_norm_g[i], ang_row, ang_col)
        merged = (jax.nn.sigmoid(gate_m) * (y_m @ w_branch_m[i])
                  + jax.nn.sigmoid(gate_a) * (y_a @ w_branch_a[i]))
        x = x + merged @ w_out[i]
        x = x + hier_moe(rmsnorm(x, norm2_g[i]), w_router_group[i], b_router_group[i],
                         w_router_expert[i], b_router_expert[i],
                         w_exp_gate[i], w_exp_up[i], w_exp_down[i])
        ple_gate = jax.nn.sigmoid(rmsnorm(x, ple_norm_g[i]) @ w_ple_gate[i])
        x = x + ple_gate * (p[i] @ w_ple_proj[i])
    return rmsnorm(x, final_norm_g)
```

```cpp
#include <hip/hip_runtime.h>
#include <cstdio>
#include <cstdint>
#include <type_traits>

#ifndef MK_PER_PHASE
#define MK_PER_PHASE 0
#endif

#define LAS __attribute__((address_space(3)))
#define GAS __attribute__((address_space(1)))
typedef unsigned short bf16_t;
typedef short bf16x8 __attribute__((ext_vector_type(8)));
typedef short s16x4 __attribute__((ext_vector_type(4)));
typedef float f32x4 __attribute__((ext_vector_type(4)));
typedef float f32x2 __attribute__((ext_vector_type(2)));
typedef float f32x16 __attribute__((ext_vector_type(16)));
typedef unsigned u32x4 __attribute__((ext_vector_type(4)));
typedef unsigned u32x2 __attribute__((ext_vector_type(2)));
typedef int i32x4 __attribute__((ext_vector_type(4)));

constexpr int T_TOK = 32768, DM = 2048, SEQ = 2048, NBATCH = 16, DEPTH = 2;
constexpr int INW = 9760, LDZ = 9728;
constexpr int ZQM = 0, ZKM = 1024, ZVM = 2048, ZOM = 3072, ZQA = 4096, ZKA = 5120, ZVA = 5376, ZGM = 5632, ZGA = 7680;
constexpr int NEXP = 32, DFF = 512, PLE = 256, LISTCAP = 32768;
constexpr float EPS = 1e-6f;
constexpr float QA = 25.4f, QW_2048 = 127.0f * 45.254833995939045f / 4.0f, QW_1024 = 127.0f * 32.0f / 4.0f, QM = 63.5f, QA2 = 24.0f, QH = 127.0f / 8.0f,
    QY = 127.0f / 4.0f, QP = 127.0f / 4.5f, QYA = 254.0f,
    QW_512 = 127.0f * 22.627416997969522f / 4.0f;

constexpr size_t MiB = 1u << 20;
constexpr size_t WS_CTL = 0, CTL_ZERO_BYTES = 1 * MiB;
constexpr size_t WS_GATES = 1 * MiB;
constexpr size_t WS_TOKE = 5 * MiB;
constexpr size_t WS_TOKP = WS_TOKE + 256 * 1024;
constexpr size_t WS_TOKW = WS_TOKP + 256 * 1024;
constexpr size_t WS_LIST = 6 * MiB;
constexpr size_t WS_PB = 10 * MiB;
constexpr size_t WS_WIN = 26 * MiB;
constexpr size_t WS_WG = 64 * MiB;
constexpr size_t WS_WR = WS_WG + 256 * 1024;
constexpr size_t WS_WBM = 65 * MiB, WS_WBA = 69 * MiB, WS_WOUT = 73 * MiB, WS_WPG = 81 * MiB, WS_WPP = 89 * MiB;
constexpr size_t WS_WGU = 90 * MiB;
constexpr size_t WS_WD = 218 * MiB;
constexpr size_t WS_HB = 282 * MiB;
constexpr size_t WS_HFW = 410 * MiB, WS_HBW = 474 * MiB;
constexpr size_t WS_Z = 538 * MiB;
constexpr size_t WS_HID = WS_Z;
constexpr size_t WS_YS = WS_Z + 72 * MiB;
constexpr size_t WS_XF = WS_Z + 224 * MiB;
constexpr size_t WS_PP = WS_Z + 360 * MiB;
constexpr size_t WS_END = WS_Z + 608 * MiB;
constexpr size_t WS_HB8 = WS_END;
constexpr size_t WS_YA8 = WS_HB8 + 64 * MiB;
constexpr size_t WS_PART = WS_YA8 + 32 * MiB;
constexpr size_t WS_FROW = WS_PART + 4 * MiB;
constexpr size_t WS_RIN = WS_FROW + 1 * MiB;
constexpr size_t WS_LISTF = WS_RIN + 1 * MiB;
constexpr size_t WS_END2 = WS_LISTF + 4 * MiB;
constexpr int CW_BAR = 4096;
constexpr int CW_CNT = 16384;

constexpr int SCR_BYTES = 139264;
constexpr int MISC_OFF = SCR_BYTES;
constexpr int LDS_BYTES = SCR_BYTES + 1024;
constexpr int NWAVES = 8;

#define RLX_AGENT __ATOMIC_RELAXED, __HIP_MEMORY_SCOPE_AGENT
#define LDS_WAIT() asm volatile("s_waitcnt lgkmcnt(0)" ::: "memory")
#define VM_WAIT() asm volatile("s_waitcnt vmcnt(0)" ::: "memory")

typedef __bf16 bf16x2n_t __attribute__((ext_vector_type(2))); typedef float f32x2n_t __attribute__((ext_vector_type(2)));
__device__ __forceinline__ unsigned cvt_pk_bf16(float lo, float hi) { const f32x2n_t v = {lo, hi}; return __builtin_bit_cast(unsigned, __builtin_convertvector(v, bf16x2n_t)); }
__device__ __forceinline__ float bf_lo(unsigned w) { return __uint_as_float(w << 16); }
__device__ __forceinline__ float bf_hi(unsigned w) { return __uint_as_float(w & 0xffff0000u); }
__device__ __forceinline__ float bf2f(unsigned short b) { return __uint_as_float(((unsigned)b) << 16); }
__device__ __forceinline__ unsigned q8(float v, float s) { return (unsigned)(int)rintf(fminf(fmaxf(v * s, -127.f), 127.f)) & 0xffu; }
typedef short s16x2_t __attribute__((ext_vector_type(2)));
__device__ __forceinline__ unsigned q8x4(const f32x4& y, float s) {
    constexpr float K = 32768.0f / (128.0f * 32767.0f); const float c1 = s * K, c0 = 0.5f * K;
    const s16x2_t p = __builtin_amdgcn_cvt_pknorm_i16(fmaf(y.x, c1, c0), fmaf(y.y, c1, c0)), q = __builtin_amdgcn_cvt_pknorm_i16(fmaf(y.z, c1, c0), fmaf(y.w, c1, c0));
    return __builtin_amdgcn_perm(__builtin_bit_cast(unsigned, q), __builtin_bit_cast(unsigned, p), 0x07050301u);
}
__device__ __forceinline__ unsigned qu8x4(const f32x4& y) { return (unsigned)(y.x * 255.f + 0.5f) | ((unsigned)(y.y * 255.f + 0.5f) << 8) | ((unsigned)(y.z * 255.f + 0.5f) << 16) | ((unsigned)(y.w * 255.f + 0.5f) << 24); }
__device__ __forceinline__ f32x4 u8x4_f(unsigned w) { return (f32x4){(float)(w & 0xffu), (float)((w >> 8) & 0xffu), (float)((w >> 16) & 0xffu), (float)(w >> 24)}; }
__device__ __forceinline__ f32x4 s8x4_f(unsigned w) { const int a = (int)w; return (f32x4){(float)((a << 24) >> 24), (float)((a << 16) >> 24), (float)((a << 8) >> 24), (float)(a >> 24)}; }
__device__ __forceinline__ float sigmoidf_(float x) { return __builtin_amdgcn_rcpf(1.0f + __expf(-x)); }
template <int M> __device__ __forceinline__ float xor_shfl(float v) { static_assert(M >= 1 && M <= 16, "mask"); return __int_as_float(__builtin_amdgcn_ds_swizzle(__float_as_int(v), (M << 10) | 0x1f)); }
__device__ __forceinline__ float wave_sum(float v) {
    v += xor_shfl<1>(v); v += xor_shfl<2>(v); v += xor_shfl<4>(v); v += xor_shfl<8>(v); v += xor_shfl<16>(v);
    auto rr = __builtin_amdgcn_permlane32_swap(__float_as_uint(v), __float_as_uint(v), false, false);
    return __uint_as_float(rr[0]) + __uint_as_float(rr[1]);
}
__device__ __forceinline__ float lane_get(float v, int src_lane) { return __int_as_float(__builtin_amdgcn_ds_bpermute(src_lane << 2, __float_as_int(v))); }

#define XB_TMO      128
#define XB_XCNT(j)  (256  + 64 * (j))
#define XB_XSUB(j)  (1280 + 64 * (j))
#define XB_XGEN(j)  (2304 + 64 * (j))
#define XB_TOP      3328
#define XB_TOPGEN   3392
#define XCD_BAR_WORDS 3456
#define XB_SPIN_CAP (1u << 18)
__device__ __forceinline__ unsigned xb_ld(unsigned* p)              { return __hip_atomic_load(p, __ATOMIC_RELAXED, __HIP_MEMORY_SCOPE_AGENT); }
__device__ __forceinline__ unsigned xb_add(unsigned* p, unsigned v) { return __hip_atomic_fetch_add(p, v, __ATOMIC_RELAXED, __HIP_MEMORY_SCOPE_AGENT); }
__device__ __forceinline__ unsigned xb_xcc_id() { return (unsigned)__builtin_amdgcn_s_getreg((3 << 11) | 20) & 0xFu; }
#define XB_SPIN(cond, bar) do { unsigned _sp = 0; while (cond) { __builtin_amdgcn_s_sleep(1); \
    if ((++_sp & 255u) == 0u) { if (xb_ld(&(bar)[XB_TMO])) break; if (_sp > XB_SPIN_CAP) { atomicAdd(&(bar)[XB_TMO], 1u); break; } } } } while (0)
struct XcdBarrier { unsigned* bar; unsigned x; volatile LAS unsigned* st; };
__device__ __forceinline__ XcdBarrier xcd_barrier_post(unsigned* bar, volatile LAS unsigned* st) {
    XcdBarrier b; b.bar = bar; b.x = xb_xcc_id(); b.st = st;
    if (threadIdx.x == 0) (void)xb_add(&bar[XB_XCNT(b.x)], 1u);
    return b;
}
__device__ __forceinline__ void xcd_barrier_complete(unsigned* bar, unsigned x, unsigned& nloc, unsigned& nx) {
    const unsigned G = gridDim.x * gridDim.y * gridDim.z;
    unsigned sum, cnt, mine, sp = 0u;
    for (;;) {
        sum = 0u; cnt = 0u; mine = 0u;
#pragma unroll
        for (unsigned j = 0; j < 16; ++j) { const unsigned c = xb_ld(&bar[XB_XCNT(j)]); sum += c; cnt += (c > 0u) ? 1u : 0u; mine = (j == x) ? c : mine; }
        if (sum == G) break;
        __builtin_amdgcn_s_sleep(1);
        if ((++sp & 255u) == 0u) { if (xb_ld(&bar[XB_TMO])) break; if (sp > XB_SPIN_CAP) { atomicAdd(&bar[XB_TMO], 1u); break; } }
    }
    nloc = mine > 0u ? mine : 1u; nx = cnt > 0u ? cnt : 1u;
}
__device__ __forceinline__ void xcd_barrier(const XcdBarrier& b) {
    asm volatile("s_waitcnt vmcnt(0)" ::: "memory");
    __syncthreads();
    if (threadIdx.x == 0) {
        unsigned* bar = b.bar;
        __builtin_amdgcn_s_waitcnt(0);
        unsigned nloc = b.st[0], nx = b.st[1];
        if (nloc == 0u) { xcd_barrier_complete(bar, b.x, nloc, nx); b.st[0] = nloc; b.st[1] = nx; }
        const unsigned old = xb_add(&bar[XB_XSUB(b.x)], 1u);
        const unsigned gen = old / nloc;
        if (old + 1u == (gen + 1u) * nloc) {
            __builtin_amdgcn_fence(__ATOMIC_RELEASE, "agent");
            asm volatile("s_waitcnt vmcnt(0)" ::: "memory");
            const unsigned og = xb_add(&bar[XB_TOP], 1u);
            const unsigned tg = og / nx;
            if (og + 1u == (tg + 1u) * nx) xb_add(&bar[XB_TOPGEN], 1u);
            else XB_SPIN(xb_ld(&bar[XB_TOPGEN]) == tg, bar);
            __builtin_amdgcn_fence(__ATOMIC_ACQUIRE, "agent");
            xb_add(&bar[XB_XGEN(b.x)], 1u);
            asm volatile("s_waitcnt vmcnt(0)" ::: "memory");
        } else {
            XB_SPIN(xb_ld(&bar[XB_XGEN(b.x)]) == gen, bar);
            __builtin_amdgcn_fence(__ATOMIC_ACQUIRE, "agent");
            asm volatile("s_waitcnt vmcnt(0)" ::: "memory");
        }
    }
    __syncthreads();
}

namespace pg8 {
__device__ __forceinline__ int pg8_lane() { int l; asm volatile("v_mbcnt_lo_u32_b32 %0, -1, 0\n\tv_mbcnt_hi_u32_b32 %0, -1, %0" : "=v"(l)); return l; }
constexpr int BM = 256, BK = 64, HALF = 128, HTB = HALF * BK * 2, STAGE_BYTES = 8 * HTB, NXCD = 8, WGM = 4;
__host__ __device__ __forceinline__ int lds_byte(int r, int c) { const int st = (r >> 4) * 2 + (c >> 5), rr = r & 15, cc = c & 31, ob = rr * 64 + cc * 2; return st * 1024 + (ob ^ (((ob >> 9) & 1) << 5)); }
__host__ __device__ __forceinline__ void stage_rc(int b, int& R, int& C) { const int st = b / 1024, sb = b % 1024, swz = sb ^ (((sb >> 9) & 1) << 5); R = (st >> 1) * 16 + swz / 64; C = (st & 1) * 32 + (swz % 64) / 2; }
__host__ __device__ __forceinline__ int sgq(int fq) { return ((fq & 1) << 1) | (fq >> 1); }
__host__ __device__ __forceinline__ int perm32(int rho) { const int n = rho >> 4, i = rho & 15; return 8 * sgq(i >> 2) + 4 * n + (i & 3); }
struct Unit { int pm, pn, e, aux; };
__device__ __forceinline__ int xcd_remap(int L, int nwg) { const int q = nwg / NXCD, r = nwg % NXCD, xcd = L % NXCD, off = L / NXCD; return (xcd < r ? xcd * (q + 1) : r * (q + 1) + (xcd - r) * q) + off; }

struct DenseSched {
    static constexpr bool GATHER = false;
    const char* A; const char* Bt; unsigned ldaB, ldbB; int nM, nN, nwg, G, c;
    __device__ __forceinline__ void init(const void* A_, int lda, const void* Bt_, int K, int M, int N, int G_, int c_) { A = (const char*)A_; Bt = (const char*)Bt_; ldaB = (unsigned)lda * 2u; ldbB = (unsigned)K * 2u; nM = M / BM; nN = N / BM; nwg = nM * nN; G = G_; c = c_; }
    __device__ __forceinline__ bool next(int i, Unit& u) const {
        const long L = (long)i * G + c; if (L >= nwg) return false;
        const int wgid = xcd_remap((int)L, nwg);
        const int nig = WGM * nN, gid = wgid / nig, fm = gid * WGM, gsz = (nM - fm) < WGM ? (nM - fm) : WGM;
        u.pm = fm + ((wgid % nig) % gsz); u.pn = (wgid % nig) / gsz; u.e = 0; u.aux = 0; return true;
    }
    __device__ __forceinline__ const char* a_tile(const Unit& u) const { return A + (size_t)u.pm * BM * ldaB; }
    __device__ __forceinline__ const char* b_tile(const Unit& u) const { return Bt + (size_t)u.pn * BM * ldbB; }
    __device__ __forceinline__ unsigned row_index(const Unit&, int) const { return 0u; }
};
struct MoeUpSched {
    static constexpr bool GATHER = true;
    const char* A; const char* Bt; unsigned ldaB, ldbB; const int* list; const volatile LAS int* mcnt; const volatile LAS int* mcum; int nwg, G, c;
    __device__ __forceinline__ bool next(int i, Unit& u) const {
        const long L = (long)i * G + c; if (L >= nwg) return false;
        const int wgid = xcd_remap((int)L, nwg), RB = wgid >> 2; int e = 0;
        for (int j = 1; j < NEXP; ++j) e = (mcum[j] <= RB) ? j : e;
        e = __builtin_amdgcn_readfirstlane(e); u.pm = RB; u.pn = wgid & 3; u.e = e; u.aux = __builtin_amdgcn_readfirstlane(RB - mcum[e]); return true;
    }
    __device__ __forceinline__ const char* a_tile(const Unit&) const { return A; }
    __device__ __forceinline__ const char* b_tile(const Unit& u) const { return Bt + ((size_t)u.e * 1024 + (size_t)u.pn * BM) * ldbB; }
    __device__ __forceinline__ unsigned row_index(const Unit& u, int r) const { const int pos = u.aux * BM + r; return pos < mcnt[u.e] ? (unsigned)list[(size_t)u.e * LISTCAP + pos] : 0u; }
};
struct MoeDownSched {
    static constexpr bool GATHER = false;
    const char* A; const char* Bt; unsigned ldaB, ldbB; const volatile LAS int* mcum; int nwg, G, c;
    __device__ __forceinline__ bool next(int i, Unit& u) const {
        const long L = (long)i * G + c; if (L >= nwg) return false;
        const int wgid = xcd_remap((int)L, nwg), RB = wgid >> 3; int e = 0;
        for (int j = 1; j < NEXP; ++j) e = (mcum[j] <= RB) ? j : e;
        e = __builtin_amdgcn_readfirstlane(e); u.pm = RB; u.pn = wgid & 7; u.e = e; u.aux = __builtin_amdgcn_readfirstlane(RB - mcum[e]); return true;
    }
    __device__ __forceinline__ const char* a_tile(const Unit& u) const { return A + (size_t)u.pm * BM * ldaB; }
    __device__ __forceinline__ const char* b_tile(const Unit& u) const { return Bt + ((size_t)u.e * 2048 + (size_t)u.pn * BM) * ldbB; }
    __device__ __forceinline__ unsigned row_index(const Unit&, int) const { return 0u; }
};

__device__ __forceinline__ u32x4 pack8(const f32x4& v0, const f32x4& v1) { u32x4 w; w.x = cvt_pk_bf16(v0[0], v0[1]); w.y = cvt_pk_bf16(v0[2], v0[3]); w.z = cvt_pk_bf16(v1[0], v1[1]); w.w = cvt_pk_bf16(v1[2], v1[3]); return w; }
__device__ __forceinline__ u32x4 widen16(const u32x2& p0, const u32x2& p1) {
    const auto rx = __builtin_amdgcn_permlane32_swap(p0.x, p1.x, false, false); const auto ry = __builtin_amdgcn_permlane32_swap(p0.y, p1.y, false, false);
    return (u32x4){rx[0], ry[0], rx[1], ry[1]}; }
__device__ __forceinline__ void narrow16(const u32x4& w, u32x2& p0, u32x2& p1) {
    const auto rx = __builtin_amdgcn_permlane32_swap(w.x, w.z, false, false); const auto ry = __builtin_amdgcn_permlane32_swap(w.y, w.w, false, false);
    p0.x = rx[0]; p0.y = ry[0]; p1.x = rx[1]; p1.y = ry[1]; }
__device__ __forceinline__ void unpack8(const u32x4& w, f32x4& v0, f32x4& v1) { v0 = (f32x4){bf_lo(w.x), bf_hi(w.x), bf_lo(w.y), bf_hi(w.y)}; v1 = (f32x4){bf_lo(w.z), bf_hi(w.z), bf_lo(w.w), bf_hi(w.w)}; }
__device__ __forceinline__ f32x4 sig4s(const f32x4& v, float k) { return (f32x4){__builtin_amdgcn_rcpf(1.0f + __builtin_amdgcn_exp2f(v[0] * k)), __builtin_amdgcn_rcpf(1.0f + __builtin_amdgcn_exp2f(v[1] * k)), __builtin_amdgcn_rcpf(1.0f + __builtin_amdgcn_exp2f(v[2] * k)), __builtin_amdgcn_rcpf(1.0f + __builtin_amdgcn_exp2f(v[3] * k))}; }
__device__ __forceinline__ f32x4 sig4(const f32x4& v) { return (f32x4){sigmoidf_(v[0]), sigmoidf_(v[1]), sigmoidf_(v[2]), sigmoidf_(v[3])}; }

struct EpiZ {
    static constexpr bool PERM = true;
    bf16_t* Z; float dq;
    __device__ __forceinline__ void operator()(const f32x4 (&acc)[2][2][4][2], const Unit& u, int wr, int wc, int fr, int fq) const {
        const int row0 = u.pm * BM + wr * 64 + fr, col0 = u.pn * BM + wc * 32 + 8 * sgq(fq); const float kk = -dq * 1.4426950408889634f;
        const bool sg = (u.pn >= 12 && u.pn < 16) || u.pn >= 22; const float sc = (u.pn < 4 ? 0.08838834764831845f : 1.0f) * dq; const int gb = u.pn < 16 ? ZOM : (u.pn < 30 ? ZGM : ZGA);
        if (sg) {
#pragma unroll
            for (int ai = 0; ai < 2; ++ai)
#pragma unroll
                for (int mp = 0; mp < 2; ++mp) { unsigned char* rowp = (unsigned char*)(Z + (size_t)(row0 + ai * HALF + (2 * mp + (fq >> 1)) * 16) * LDZ + gb) + (u.pn * BM + wc * 32 + 16 * (fq & 1) - gb);
#pragma unroll
                    for (int bj = 0; bj < 2; ++bj) { u32x2 o0, o1; o0.x = qu8x4(sig4s(acc[ai][bj][2 * mp][0], kk)); o0.y = qu8x4(sig4s(acc[ai][bj][2 * mp][1], kk)); o1.x = qu8x4(sig4s(acc[ai][bj][2 * mp + 1][0], kk)); o1.y = qu8x4(sig4s(acc[ai][bj][2 * mp + 1][1], kk));
                        *(u32x4*)(rowp + bj * HALF) = widen16(o0, o1); }
                    asm volatile("" ::: "memory"); }
        } else {
#pragma unroll
            for (int ai = 0; ai < 2; ++ai)
#pragma unroll
                for (int m = 0; m < 4; ++m) { bf16_t* rowp = Z + (size_t)(row0 + ai * HALF + m * 16) * LDZ + col0;
#pragma unroll
                    for (int bj = 0; bj < 2; ++bj) *(u32x4*)(rowp + bj * HALF) = pack8(acc[ai][bj][m][0] * sc, acc[ai][bj][m][1] * sc);
                    asm volatile("" ::: "memory"); }
        }
    }
};
template <bool SECOND> struct EpiMerge {
    static constexpr bool PERM = true;
    const bf16_t* Z; unsigned char* MG; unsigned char* M8; float dq;
    __device__ __forceinline__ void operator()(const f32x4 (&acc)[2][2][4][2], const Unit& u, int wr, int wc, int fr, int fq) const {
        const int row0 = u.pm * BM + wr * 64 + fr, col0 = u.pn * BM + wc * 32 + 8 * sgq(fq);
        u32x4 gww[2][2][2], pww[2][2][2];
#pragma unroll
        for (int ai = 0; ai < 2; ++ai)
#pragma unroll
            for (int mp = 0; mp < 2; ++mp) { const size_t r = (size_t)(row0 + ai * HALF + (2 * mp + (fq >> 1)) * 16);
#pragma unroll
                for (int bj = 0; bj < 2; ++bj) { const int c = u.pn * BM + wc * 32 + 16 * (fq & 1) + bj * HALF;
                    gww[ai][mp][bj] = *(const u32x4*)((const unsigned char*)(Z + r * LDZ + (SECOND ? ZGA : ZGM)) + c);
                    if (SECOND) pww[ai][mp][bj] = *(const u32x4*)(MG + r * DM + c); } }
        asm volatile("" ::: "memory");
#pragma unroll
        for (int ai = 0; ai < 2; ++ai)
#pragma unroll
            for (int mp = 0; mp < 2; ++mp) { const size_t r = (size_t)(row0 + ai * HALF + (2 * mp + (fq >> 1)) * 16);
#pragma unroll
                for (int bj = 0; bj < 2; ++bj) { const int c = u.pn * BM + wc * 32 + 16 * (fq & 1) + bj * HALF; u32x2 o[2], gq[2], pq[2];
                    narrow16(gww[ai][mp][bj], gq[0], gq[1]); if (SECOND) narrow16(pww[ai][mp][bj], pq[0], pq[1]);
#pragma unroll
                    for (int q = 0; q < 2; ++q) { const int m = 2 * mp + q;
                        const f32x4 g0 = u8x4_f(gq[q].x), g1 = u8x4_f(gq[q].y);
                        const f32x4 v0 = acc[ai][bj][m][0] * g0, v1 = acc[ai][bj][m][1] * g1;
                        if (SECOND) { const float cq = dq * QM; o[q].x = q8x4(v0 * cq + s8x4_f(pq[q].x), 1.0f); o[q].y = q8x4(v1 * cq + s8x4_f(pq[q].y), 1.0f); }
                        else { o[q].x = q8x4(v0, dq * QM); o[q].y = q8x4(v1, dq * QM); } }
                    *(u32x4*)((SECOND ? M8 : MG) + r * DM + c) = widen16(o[0], o[1]); } }
    }
};
struct EpiResid {
    static constexpr bool PERM = false;
    const float* xin; float* xout;
    __device__ __forceinline__ void operator()(const f32x4 (&acc)[2][2][4][2], const Unit& u, int wr, int wc, int fr, int fq) const {
        const int row0 = u.pm * BM + wr * 64 + fr, col0 = u.pn * BM + wc * 32 + 4 * fq;
#pragma unroll
        for (int ai = 0; ai < 2; ++ai)
#pragma unroll
            for (int m = 0; m < 4; ++m) { const size_t off = (size_t)(row0 + ai * HALF + m * 16) * DM + col0;
#pragma unroll
                for (int bj = 0; bj < 2; ++bj)
#pragma unroll
                    for (int n = 0; n < 2; ++n) { const f32x4 xv = *(const f32x4*)(xin + off + bj * HALF + n * 16); *(f32x4*)(xout + off + bj * HALF + n * 16) = xv + acc[ai][bj][m][n]; }
                asm volatile("" ::: "memory"); }
    }
};
struct EpiResidQ {
    static constexpr bool PERM = true;
    const float* xin32; const bf16_t* xin16; bf16_t* xout; unsigned char* A8; const float* g2; const float* rin; float* part; float dq;
    __device__ __forceinline__ void step(const f32x4 (&acc)[2][2][4][2], const Unit& u, int wc, int fq, int ai, int m, int row, size_t off, float rp, const f32x4 (&gv)[2][2], f32x4 (&y)[2][2], u32x2 (&o8)[2], float& keep) const {
        float ss = 0.f;
#pragma unroll
        for (int bj = 0; bj < 2; ++bj) { const f32x4 y0 = y[bj][0] + acc[ai][bj][m][0] * dq, y1 = y[bj][1] + acc[ai][bj][m][1] * dq;
            *(u32x4*)(xout + off + bj * HALF) = pack8(y0, y1);
            ss += (y0[0] * y0[0] + y0[1] * y0[1]) + (y0[2] * y0[2] + y0[3] * y0[3]) + (y1[0] * y1[0] + y1[1] * y1[1]) + (y1[2] * y1[2] + y1[3] * y1[3]);
            o8[bj].x = q8x4(y0 * gv[bj][0], rp); o8[bj].y = q8x4(y1 * gv[bj][1], rp); }
        ss += xor_shfl<16>(ss);
        { auto rr = __builtin_amdgcn_permlane32_swap(__float_as_uint(ss), __float_as_uint(ss), false, false); ss = __uint_as_float(rr[0]) + __uint_as_float(rr[1]); }
        keep = (fq == m) ? ss : keep;
    }
    __device__ __forceinline__ void operator()(const f32x4 (&acc)[2][2][4][2], const Unit& u, int wr, int wc, int fr, int fq) const {
        const int row0 = u.pm * BM + wr * 64 + fr, col0 = u.pn * BM + wc * 32 + 8 * sgq(fq);
        f32x4 gv[2][2]; float rp[2][4];
#pragma unroll
        for (int bj = 0; bj < 2; ++bj)
#pragma unroll
            for (int n = 0; n < 2; ++n) gv[bj][n] = *(const f32x4*)(g2 + col0 + bj * HALF + 4 * n);
        const int lane_ = 16 * fq + fr; float keep[2] = {0.f, 0.f};
#pragma unroll
        for (int ai = 0; ai < 2; ++ai) { const float rv = rin[u.pm * BM + ai * HALF + wr * 64 + lane_];
#pragma unroll
            for (int m = 0; m < 4; ++m) rp[ai][m] = __int_as_float(__builtin_amdgcn_ds_bpermute(4 * (16 * m + fr), __float_as_int(rv))); }
        if (xin32) {
#pragma unroll
            for (int q = 0; q < 4; ++q) { const int ai = q >> 1; f32x4 xv[2][2][2];
#pragma unroll
                for (int mm = 0; mm < 2; ++mm) { const size_t off = (size_t)(row0 + ai * HALF + (2 * (q & 1) + mm) * 16) * DM + col0;
#pragma unroll
                    for (int bj = 0; bj < 2; ++bj) { xv[mm][bj][0] = *(const f32x4*)(xin32 + off + bj * HALF); xv[mm][bj][1] = *(const f32x4*)(xin32 + off + bj * HALF + 4); } }
                asm volatile("" ::: "memory");
                u32x2 o8[2][2];
#pragma unroll
                for (int mm = 0; mm < 2; ++mm) { const int m = 2 * (q & 1) + mm; const int row = row0 + ai * HALF + m * 16; step(acc, u, wc, fq, ai, m, row, (size_t)row * DM + col0, rp[ai][m] * QA2, gv, xv[mm], o8[mm], keep[ai]); }
#pragma unroll
                for (int bj = 0; bj < 2; ++bj) *(u32x4*)(A8 + (size_t)(row0 + ai * HALF + (2 * (q & 1) + (fq >> 1)) * 16) * DM + u.pn * BM + wc * 32 + 16 * (fq & 1) + bj * HALF) = widen16(o8[0][bj], o8[1][bj]);
                asm volatile("" ::: "memory"); }
        } else {
#pragma unroll
            for (int ai = 0; ai < 2; ++ai) { u32x4 xw[4][2];
#pragma unroll
                for (int m = 0; m < 4; ++m) { const size_t off = (size_t)(row0 + ai * HALF + m * 16) * DM + col0;
#pragma unroll
                    for (int bj = 0; bj < 2; ++bj) xw[m][bj] = *(const u32x4*)(xin16 + off + bj * HALF); }
                asm volatile("" ::: "memory");
#pragma unroll
                for (int mp = 0; mp < 2; ++mp) { u32x2 o8[2][2];
#pragma unroll
                    for (int mm = 0; mm < 2; ++mm) { const int m = 2 * mp + mm; const int row = row0 + ai * HALF + m * 16; f32x4 y[2][2];
#pragma unroll
                        for (int bj = 0; bj < 2; ++bj) unpack8(xw[m][bj], y[bj][0], y[bj][1]);
                        step(acc, u, wc, fq, ai, m, row, (size_t)row * DM + col0, rp[ai][m] * QA2, gv, y, o8[mm], keep[ai]); }
#pragma unroll
                    for (int bj = 0; bj < 2; ++bj) *(u32x4*)(A8 + (size_t)(row0 + ai * HALF + (2 * mp + (fq >> 1)) * 16) * DM + u.pn * BM + wc * 32 + 16 * (fq & 1) + bj * HALF) = widen16(o8[0][bj], o8[1][bj]); }
                asm volatile("" ::: "memory"); }
        }
#pragma unroll
        for (int ai = 0; ai < 2; ++ai) part[(size_t)(u.pn * 4 + wc) * T_TOK + u.pm * BM + ai * HALF + wr * 64 + lane_] = keep[ai];
    }
};
struct EpiSwiGLU {
    static constexpr bool PERM = true;
    unsigned char* HID;
    const float* listf; const volatile LAS int* mcnt; float dq;
    __device__ __forceinline__ void operator()(const f32x4 (&acc)[2][2][4][2], const Unit& u, int wr, int wc, int fr, int fq) const {
        const int row0 = u.pm * BM + wr * 64 + fr, col0 = u.pn * HALF + wc * 32 + 8 * sgq(fq);
        float f_[2][4]; const int cnt_ = mcnt[u.e];
#pragma unroll
        for (int ai = 0; ai < 2; ++ai)
            { const int pos_ = u.aux * BM + ai * HALF + wr * 64 + 16 * fq + fr; const float fv = listf[(size_t)u.e * LISTCAP + (pos_ < cnt_ ? pos_ : 0)];
#pragma unroll
              for (int m = 0; m < 4; ++m) f_[ai][m] = __int_as_float(__builtin_amdgcn_ds_bpermute(4 * (16 * m + fr), __float_as_int(fv))); }
        asm volatile("" ::: "memory");
#pragma unroll
        for (int ai = 0; ai < 2; ++ai)
#pragma unroll
            for (int mp = 0; mp < 2; ++mp) { u32x2 o[2];
#pragma unroll
                for (int q = 0; q < 2; ++q) { const int m = 2 * mp + q; f32x4 h[2];
#pragma unroll
                    for (int n = 0; n < 2; ++n) { const float fd = f_[ai][m] * dq; const f32x4 g = acc[ai][0][m][n] * fd, up = acc[ai][1][m][n] * fd; h[n] = g * sig4(g) * up; }
                    o[q].x = q8x4(h[0], QH); o[q].y = q8x4(h[1], QH); }
                *(u32x4*)(HID + (size_t)(row0 + ai * HALF + (2 * mp + (fq >> 1)) * 16) * DFF + u.pn * HALF + wc * 32 + 16 * (fq & 1)) = widen16(o[0], o[1]); }
    }
};
struct EpiBf16 {
    static constexpr bool PERM = true;
    bf16_t* O; int ldc;
    __device__ __forceinline__ void operator()(const f32x4 (&acc)[2][2][4][2], const Unit& u, int wr, int wc, int fr, int fq) const {
        const int row0 = u.pm * BM + wr * 64 + fr, col0 = u.pn * BM + wc * 32 + 8 * sgq(fq);
        float one_ = 1.0f; asm volatile("" : "+v"(one_));
#pragma unroll
        for (int ai = 0; ai < 2; ++ai)
#pragma unroll
            for (int m = 0; m < 4; ++m) { bf16_t* rowp = O + (size_t)(row0 + ai * HALF + m * 16) * ldc + col0;
#pragma unroll
                for (int bj = 0; bj < 2; ++bj) *(u32x4*)(rowp + bj * HALF) = pack8(acc[ai][bj][m][0] * one_, acc[ai][bj][m][1] * one_); }
    }
};
struct EpiI8 {
    static constexpr bool PERM = true;
    unsigned char* O; int ldc; float q;
    __device__ __forceinline__ void operator()(const f32x4 (&acc)[2][2][4][2], const Unit& u, int wr, int wc, int fr, int fq) const {
        const int row0 = u.pm * BM + wr * 64 + fr, col0 = u.pn * BM + wc * 32 + 8 * sgq(fq);
#pragma unroll
        for (int ai = 0; ai < 2; ++ai)
#pragma unroll
            for (int mp = 0; mp < 2; ++mp) { unsigned char* rowp = O + (size_t)(row0 + ai * HALF + (2 * mp + (fq >> 1)) * 16) * ldc + u.pn * BM + wc * 32 + 16 * (fq & 1);
#pragma unroll
                for (int bj = 0; bj < 2; ++bj) { u32x2 o0, o1; o0.x = q8x4(acc[ai][bj][2 * mp][0], q); o0.y = q8x4(acc[ai][bj][2 * mp][1], q); o1.x = q8x4(acc[ai][bj][2 * mp + 1][0], q); o1.y = q8x4(acc[ai][bj][2 * mp + 1][1], q);
                    *(u32x4*)(rowp + bj * HALF) = widen16(o0, o1); }
                asm volatile("" ::: "memory"); }
    }
};
struct EpiPle {
    static constexpr bool PERM = true;
    const bf16_t* xin; bf16_t* xout; const unsigned char* PP; float dq;
    __device__ __forceinline__ void operator()(const f32x4 (&acc)[2][2][4][2], const Unit& u, int wr, int wc, int fr, int fq) const {
        const int row0 = u.pm * BM + wr * 64 + fr, col0 = u.pn * BM + wc * 32 + 8 * sgq(fq); const float kk = -dq * 1.4426950408889634f;
#pragma unroll
        for (int ai = 0; ai < 2; ++ai) { u32x4 xw[4][2]; u32x4 pww[2][2];
#pragma unroll
            for (int m = 0; m < 4; ++m) { const size_t off = (size_t)(row0 + ai * HALF + m * 16) * DM + col0;
#pragma unroll
                for (int bj = 0; bj < 2; ++bj) xw[m][bj] = *(const u32x4*)(xin + off + bj * HALF); }
#pragma unroll
            for (int mp = 0; mp < 2; ++mp)
#pragma unroll
                for (int bj = 0; bj < 2; ++bj) pww[mp][bj] = *(const u32x4*)(PP + (size_t)(row0 + ai * HALF + (2 * mp + (fq >> 1)) * 16) * DM + u.pn * BM + wc * 32 + 16 * (fq & 1) + bj * HALF);
            asm volatile("" ::: "memory");
            u32x2 pw[4][2];
#pragma unroll
            for (int mp = 0; mp < 2; ++mp)
#pragma unroll
                for (int bj = 0; bj < 2; ++bj) narrow16(pww[mp][bj], pw[2 * mp][bj], pw[2 * mp + 1][bj]);
#pragma unroll
            for (int m = 0; m < 4; ++m) { const size_t off = (size_t)(row0 + ai * HALF + m * 16) * DM + col0;
#pragma unroll
                for (int bj = 0; bj < 2; ++bj) { f32x4 x0, x1; unpack8(xw[m][bj], x0, x1); const f32x4 p0 = s8x4_f(pw[m][bj].x) * (1.0f / QP), p1 = s8x4_f(pw[m][bj].y) * (1.0f / QP);
                    *(u32x4*)(xout + off + bj * HALF) = pack8(x0 + sig4s(acc[ai][bj][m][0], kk) * p0, x1 + sig4s(acc[ai][bj][m][1], kk) * p1); } }
            asm volatile("" ::: "memory"); }
    }
};

__device__ __forceinline__ f32x4 mma16(const bf16x8& a, const bf16x8& b, const f32x4& c) { return __builtin_amdgcn_mfma_f32_16x16x32_bf16(a, b, c, 0, 0, 0); }
__device__ __forceinline__ i32x4 mma16(const i32x4& a, const i32x4& b, const i32x4& c) { return __builtin_amdgcn_mfma_i32_16x16x64_i8(a, b, c, 0, 0, 0); }
template <class Epi, class Sched, bool I8 = false>
__device__ __forceinline__ void gemm_phase(LAS unsigned char* lds, const int K, const Sched& S, const Epi& E, const int wave_id) {
    typedef typename std::conditional<I8, i32x4, f32x4>::type acc_t; typedef typename std::conditional<I8, i32x4, bf16x8>::type frag_t;
    const int tid = (wave_id << 6) | pg8_lane();
    const int wid = __builtin_amdgcn_readfirstlane(tid >> 6), lane = tid & 63, wr = wid >> 2, wc = wid & 3, fr = lane & 15, fq = lane >> 4;
    const int nt = K / BK;
    int RA[2]; unsigned cbA[2], voffB[2];
#pragma unroll
    for (int i = 0; i < 2; ++i) { int R, C; stage_rc(tid * 16 + i * 8192, R, C); const int Rb = Epi::PERM ? ((R & ~31) + perm32(R & 31)) : R;
        RA[i] = R; cbA[i] = (unsigned)C * 2u; voffB[i] = (unsigned)Rb * S.ldbB + (unsigned)C * 2u; }
    const size_t kstep = (size_t)(BK * 2);
    const size_t hstepB = (size_t)HALF * S.ldbB;
    const size_t hstepA = (size_t)HALF * S.ldaB;
    const unsigned ldsw = (unsigned)wid * 1024u;
    const int aoff = lds_byte(wr * 64 + fr, fq * 8), boff = lds_byte(wc * 32 + fr, fq * 8);
#define PG8_SA(b, h) (((b) * 2 + (h)) * HTB)
#define PG8_SB(b, h) ((4 + (b) * 2 + (h)) * HTB)
#define PG8_STAGE(bufoff, gbase, voff) do { _Pragma("unroll") for (int _i = 0; _i < 2; ++_i) \
        __builtin_amdgcn_global_load_lds((const unsigned*)((const char*)(gbase) + (voff)[_i]), (LAS unsigned*)(lds + (bufoff) + ldsw + _i * 8192), 16, 0, 0); } while (0)
#define PG8_LDA(dst, b, h) do { _Pragma("unroll") for (int m = 0; m < 4; ++m) _Pragma("unroll") for (int k = 0; k < 2; ++k) dst[m][k] = *(const LAS frag_t*)(lds + PG8_SA(b, h) + aoff + m * 2048 + k * 1024); } while (0)
#define PG8_LDB(dst, b, h) do { _Pragma("unroll") for (int n = 0; n < 2; ++n) _Pragma("unroll") for (int k = 0; k < 2; ++k) dst[n][k] = *(const LAS frag_t*)(lds + PG8_SB(b, h) + boff + n * 2048 + k * 1024); } while (0)
#define PG8_MMA(ai, bj, At, Bt) do { __builtin_amdgcn_s_setprio(1); _Pragma("unroll") for (int m = 0; m < 4; ++m) _Pragma("unroll") for (int n = 0; n < 2; ++n) _Pragma("unroll") for (int k = 0; k < 2; ++k) \
        acc[ai][bj][m][n] = mma16(Bt[n][k], At[m][k], acc[ai][bj][m][n]); __builtin_amdgcn_s_setprio(0); } while (0)
#define PG8_WAIT_V(n) asm volatile("s_waitcnt vmcnt(" #n ")" ::: "memory")
#define PG8_WAIT_L(n) asm volatile("s_waitcnt lgkmcnt(" #n ")" ::: "memory")
#define PG8_BAR __builtin_amdgcn_s_barrier()
#define PG8_SCHED __builtin_amdgcn_sched_barrier(0)
#define PG8_OFFS(dst, U) do { _Pragma("unroll") for (int _h = 0; _h < 2; ++_h) _Pragma("unroll") for (int _i = 0; _i < 2; ++_i) \
        dst[_h][_i] = (Sched::GATHER ? S.row_index(U, _h * HALF + RA[_i]) : (unsigned)(RA[_i])) * S.ldaB + cbA[_i]; } while (0)
#define PG8_STAGE_A(bufoff, gbase, h, VO) do { if constexpr (Sched::GATHER) { PG8_STAGE(bufoff, gbase, VO[h]); } else { PG8_STAGE(bufoff, (gbase) + (h) * hstepA, VO[0]); } } while (0)
    Unit cur, nxt; int ui = 0;
    if (!S.next(0, cur)) return;
    acc_t acc[2][2][4][2];
#pragma unroll
    for (int a = 0; a < 2; ++a)
#pragma unroll
        for (int b = 0; b < 2; ++b)
#pragma unroll
            for (int m = 0; m < 4; ++m)
#pragma unroll
                for (int n = 0; n < 2; ++n) acc[a][b][m][n] = (acc_t){0, 0, 0, 0};
    frag_t At[4][2], B0[2][2], B1[2][2];
    unsigned vA[2][2], nvA[2][2];
    PG8_OFFS(vA, cur);
    const char* cA = S.a_tile(cur); const char* cB = S.b_tile(cur);
    PG8_STAGE(PG8_SB(0, 0), cB, voffB); PG8_STAGE(PG8_SB(0, 1), cB + hstepB, voffB); PG8_STAGE_A(PG8_SA(0, 0), cA, 0, vA); PG8_STAGE_A(PG8_SA(0, 1), cA, 1, vA);
    if (wr == 1) PG8_BAR;
    PG8_WAIT_V(2); PG8_BAR;
    PG8_STAGE(PG8_SB(1, 0), cB + kstep, voffB); PG8_STAGE_A(PG8_SA(1, 0), cA + kstep, 0, vA); PG8_STAGE(PG8_SB(1, 1), cB + hstepB + kstep, voffB);
    PG8_WAIT_V(6); PG8_BAR;
    for (;;) {
        const bool has_next = S.next(ui + 1, nxt);
        const char* nA = has_next ? S.a_tile(nxt) : cA; const char* nB = has_next ? S.b_tile(nxt) : cB;
        if constexpr (Sched::GATHER) { if (has_next) { PG8_OFFS(nvA, nxt); } else {
#pragma unroll
            for (int h = 0; h < 2; ++h)
#pragma unroll
                for (int i = 0; i < 2; ++i) nvA[h][i] = vA[h][i]; } }
        for (int t = 0; t < nt; t += 2) {
            const bool last = (t == nt - 2);
            const char* a1 = cA + (size_t)(t + 1) * kstep;
            const char* a2 = last ? nA : cA + (size_t)(t + 2) * kstep; const char* b2 = last ? nB : cB + (size_t)(t + 2) * kstep;
            const char* a3 = a2 + kstep; const char* b3 = b2 + kstep;
            unsigned wA[2][2];
#pragma unroll
            for (int h = 0; h < 2; ++h)
#pragma unroll
                for (int i = 0; i < 2; ++i) wA[h][i] = (Sched::GATHER && last) ? nvA[h][i] : vA[h][i];
            PG8_LDB(B0, 0, 0); PG8_LDB(B1, 0, 1); PG8_SCHED; PG8_LDA(At, 0, 0); PG8_STAGE_A(PG8_SA(1, 1), a1, 1, vA);
            PG8_WAIT_V(8); PG8_WAIT_L(0); PG8_BAR; PG8_MMA(0, 0, At, B0); PG8_MMA(0, 1, At, B1); PG8_BAR; PG8_SCHED;
            PG8_LDA(At, 0, 1); PG8_STAGE(PG8_SB(0, 0), b2, voffB); PG8_STAGE(PG8_SB(0, 1), b2 + hstepB, voffB); PG8_STAGE_A(PG8_SA(0, 0), a2, 0, wA);
            PG8_WAIT_V(8); PG8_WAIT_L(0); PG8_BAR; PG8_MMA(1, 0, At, B0); PG8_MMA(1, 1, At, B1); PG8_BAR; PG8_SCHED;
            PG8_LDB(B0, 1, 0); PG8_LDB(B1, 1, 1); PG8_SCHED; PG8_LDA(At, 1, 0); PG8_STAGE_A(PG8_SA(0, 1), a2, 1, wA);
            PG8_WAIT_V(8); PG8_WAIT_L(0); PG8_BAR; PG8_MMA(0, 0, At, B0); PG8_MMA(0, 1, At, B1); PG8_BAR; PG8_SCHED;
            PG8_LDA(At, 1, 1); PG8_STAGE(PG8_SB(1, 0), b3, voffB); PG8_STAGE(PG8_SB(1, 1), b3 + hstepB, voffB); PG8_STAGE_A(PG8_SA(1, 0), a3, 0, wA);
            PG8_WAIT_V(8); PG8_WAIT_L(0); PG8_BAR; PG8_MMA(1, 0, At, B0); PG8_MMA(1, 1, At, B1); PG8_BAR; PG8_SCHED;
        }
        if (wr == 0) PG8_BAR;
        { const int te_ = pg8_lane();
          if constexpr (I8) { f32x4 facc[2][2][4][2];
#pragma unroll
              for (int a = 0; a < 2; ++a)
#pragma unroll
                  for (int b = 0; b < 2; ++b)
#pragma unroll
                      for (int m = 0; m < 4; ++m)
#pragma unroll
                          for (int n = 0; n < 2; ++n) facc[a][b][m][n] = __builtin_convertvector(acc[a][b][m][n], f32x4);
              E(facc, cur, wr, wc, te_ & 15, (te_ >> 4) & 3); }
          else E(acc, cur, wr, wc, te_ & 15, (te_ >> 4) & 3);
        }
        if (!has_next) break;
#pragma unroll
        for (int a = 0; a < 2; ++a)
#pragma unroll
            for (int b = 0; b < 2; ++b)
#pragma unroll
                for (int m = 0; m < 4; ++m)
#pragma unroll
                    for (int n = 0; n < 2; ++n) acc[a][b][m][n] = (acc_t){0, 0, 0, 0};
        cur = nxt; cA = nA; cB = nB; ++ui;
        if constexpr (Sched::GATHER) {
#pragma unroll
        for (int h = 0; h < 2; ++h)
#pragma unroll
            for (int i = 0; i < 2; ++i) vA[h][i] = nvA[h][i]; }
        if (wr == 1) PG8_BAR;
    }
    PG8_WAIT_V(0);
    PG8_BAR;
#undef PG8_SA
#undef PG8_SB
#undef PG8_STAGE
#undef PG8_LDA
#undef PG8_LDB
#undef PG8_MMA
#undef PG8_WAIT_V
#undef PG8_WAIT_L
#undef PG8_BAR
#undef PG8_SCHED
#undef PG8_OFFS
#undef PG8_STAGE_A
}
}

namespace att {
constexpr int D = 128, NW = 8, QBLK = 32, KVBLK = 64;
constexpr float SCALE = 0.088388347648318440f;
constexpr float THR = 8.f;
constexpr int LDQ = LDZ, LDK = LDZ, LDO = LDZ;
constexpr size_t SHM_V = KVBLK * D * 2, SHM_K = KVBLK * D * 2, SHM_ATTN = 2 * SHM_V + 2 * SHM_K + NW * 64 * 4;
#define KSWZ(row, colB) ((row) * 256 + ((colB) ^ (((row) & 7) << 4)))
#define SBAR() __builtin_amdgcn_sched_barrier(0)
__device__ __forceinline__ int crow(int r, int hi) { return (r & 3) + 8 * (r >> 2) + 4 * hi; }
__device__ __forceinline__ unsigned cvtpk(float lo, float hi) { return cvt_pk_bf16(lo, hi); }
__device__ __forceinline__ void partialSM(f32x16& p0, f32x16& p1, float& m_reg, float& mn, float& alpha) {
  constexpr float C = SCALE * 1.4426950408889634f;
  float pmax = p0[0]; for (int r = 1; r < 16; ++r) pmax = fmaxf(pmax, p0[r]); for (int r = 0; r < 16; ++r) pmax = fmaxf(pmax, p1[r]);
  { auto rr = __builtin_amdgcn_permlane32_swap(__float_as_uint(pmax), __float_as_uint(pmax), false, false);
    pmax = fmaxf(__uint_as_float(rr[0]), __uint_as_float(rr[1])); }
  if (__builtin_expect(__all(pmax - m_reg <= THR / SCALE), 1)) { mn = m_reg; alpha = 1.f; }
  else { mn = fmaxf(m_reg, pmax); alpha = __builtin_amdgcn_exp2f((m_reg - mn) * C); m_reg = mn; }
  float mnC = -mn * C;
  for (int r = 0; r < 16; ++r) p0[r] = fmaf(p0[r], C, mnC); for (int r = 0; r < 16; ++r) p1[r] = fmaf(p1[r], C, mnC);
  for (int r = 0; r < 16; ++r) p0[r] = __builtin_amdgcn_exp2f(p0[r]);
}
__device__ __forceinline__ void finishSM(f32x16& p0, f32x16& p1, float alpha, float& l_reg, bf16x8& pa0, bf16x8& pa1, bf16x8& pa2, bf16x8& pa3) {
  for (int r = 0; r < 16; ++r) p1[r] = __builtin_amdgcn_exp2f(p1[r]);
  float ps = 0; for (int r = 0; r < 16; ++r) ps += p0[r]; for (int r = 0; r < 16; ++r) ps += p1[r];
  { auto rr = __builtin_amdgcn_permlane32_swap(__float_as_uint(ps), __float_as_uint(ps), false, false);
    ps = __uint_as_float(rr[0]) + __uint_as_float(rr[1]); }
  l_reg = l_reg * alpha + ps;
#define PK4(P, BASE, OUT) do { unsigned a0 = cvtpk(P[BASE + 0], P[BASE + 1]), a1 = cvtpk(P[BASE + 2], P[BASE + 3]);   \
    unsigned b0 = cvtpk(P[BASE + 4], P[BASE + 5]), b1 = cvtpk(P[BASE + 6], P[BASE + 7]);                              \
    auto r0 = __builtin_amdgcn_permlane32_swap(a0, b0, false, false); auto r1 = __builtin_amdgcn_permlane32_swap(a1, b1, false, false); \
    u32x4 w = {r0[0], r1[0], r0[1], r1[1]}; OUT = *reinterpret_cast<bf16x8*>(&w); } while (0)
  PK4(p0, 0, pa0); PK4(p0, 8, pa1); PK4(p1, 0, pa2); PK4(p1, 8, pa3);
#undef PK4
}
__device__ __forceinline__ void qkt(f32x16& p0, f32x16& p1, const bf16_t* Ks, const bf16x8* qr, int r32, int hi) {
  p0 = f32x16{}; p1 = f32x16{};
  for (int d0 = 0; d0 < 8; ++d0) { int cb = (d0 * 16 + hi * 8) * 2;
    bf16x8 b0 = *reinterpret_cast<const bf16x8*>((const char*)Ks + KSWZ(r32, cb));
    bf16x8 b1 = *reinterpret_cast<const bf16x8*>((const char*)Ks + KSWZ(32 + r32, cb));
    p0 = __builtin_amdgcn_mfma_f32_32x32x16_bf16(b0, qr[d0], p0, 0, 0, 0);
    p1 = __builtin_amdgcn_mfma_f32_32x32x16_bf16(b1, qr[d0], p1, 0, 0, 0); }
}
__device__ __forceinline__ int v_st(int k, int c) { const int kk = (k & ~0xC) | ((k & 4) << 1) | ((k & 8) >> 1); return ((kk >> 3) * 4 + (c >> 5)) * 512 + ((kk & 7) * 32 + (c & 31)) * 2; }
__device__ __forceinline__ int v_rd_base(int lane) { return ((lane & 3) << 3) | (((lane >> 2) & 3) << 6) | (((lane >> 4) & 1) << 5) | (((lane >> 5) & 1) << 8); }
constexpr int v_rd_off(int d0, int ks, int half) { return d0 * 512 + ks * 4096 + half * 2048; }
template <int OFF> __device__ __forceinline__ s16x4 tr_read(int vb) {
  s16x4 r; asm volatile("ds_read_b64_tr_b16 %0, %1 offset:%2" : "=&v"(r) : "v"(vb), "i"(OFF) : "memory"); return r;
}
template <int D0> __device__ __forceinline__ void pv_one(f32x16& od, int vb, bf16x8 pa0, bf16x8 pa1, bf16x8 pa2, bf16x8 pa3) {
  const s16x4 l0 = tr_read<v_rd_off(D0, 0, 0)>(vb), h0 = tr_read<v_rd_off(D0, 0, 1)>(vb), l1 = tr_read<v_rd_off(D0, 1, 0)>(vb), h1 = tr_read<v_rd_off(D0, 1, 1)>(vb);
  const s16x4 l2 = tr_read<v_rd_off(D0, 2, 0)>(vb), h2 = tr_read<v_rd_off(D0, 2, 1)>(vb), l3 = tr_read<v_rd_off(D0, 3, 0)>(vb), h3 = tr_read<v_rd_off(D0, 3, 1)>(vb);
  asm volatile("s_waitcnt lgkmcnt(0)" ::: "memory"); SBAR();
#define PK(L, H) (bf16x8){L[0], L[1], L[2], L[3], H[0], H[1], H[2], H[3]}
  od = __builtin_amdgcn_mfma_f32_32x32x16_bf16(pa0, PK(l0, h0), od, 0, 0, 0);
  od = __builtin_amdgcn_mfma_f32_32x32x16_bf16(pa1, PK(l1, h1), od, 0, 0, 0);
  od = __builtin_amdgcn_mfma_f32_32x32x16_bf16(pa2, PK(l2, h2), od, 0, 0, 0);
  od = __builtin_amdgcn_mfma_f32_32x32x16_bf16(pa3, PK(l3, h3), od, 0, 0, 0);
#undef PK
}
__device__ __forceinline__ void pv_d0(f32x16* o, int vb, bf16x8 pa0, bf16x8 pa1, bf16x8 pa2, bf16x8 pa3) {
  pv_one<0>(o[0], vb, pa0, pa1, pa2, pa3); pv_one<1>(o[1], vb, pa0, pa1, pa2, pa3); pv_one<2>(o[2], vb, pa0, pa1, pa2, pa3); pv_one<3>(o[3], vb, pa0, pa1, pa2, pa3);
}
__device__ __forceinline__ void attn_dense_body(const bf16_t* Qb, const bf16_t* __restrict__ Kh, const bf16_t* __restrict__ Vh, unsigned char* Ob, int seq, char* lds, const int tid, const float* qg, const int qpos0) {
  const int wid = tid >> 6, lane = tid & 63, r32 = lane & 31, hi = lane >> 5;
  bf16_t* V_lds = (bf16_t*)lds; bf16_t* K_lds = (bf16_t*)(lds + 2 * SHM_V);
  float* ws = (float*)(lds + 2 * SHM_V + 2 * SHM_K) + wid * 64; float* li_l = ws; float* al_l = ws + 32;
  float m_reg = -1e30f, l_reg = 0; f32x16 o[4] = {}; bf16x8 qr[8];
  const bf16_t* Qw = Qb + (long)(wid * QBLK + r32) * LDQ + hi * 8;
#pragma unroll
  for (int d0 = 0; d0 < 8; ++d0) qr[d0] = *reinterpret_cast<const bf16x8*>(Qw + d0 * 16);
  { float x[8][8]; float ss = 0.f;
#pragma unroll
    for (int d0 = 0; d0 < 8; ++d0) { const u32x4 w = *reinterpret_cast<const u32x4*>(&qr[d0]);
#pragma unroll
      for (int q = 0; q < 4; ++q) { x[d0][2 * q] = bf_lo(w[q]); x[d0][2 * q + 1] = bf_hi(w[q]); } }
#pragma unroll
    for (int d0 = 0; d0 < 8; ++d0)
#pragma unroll
      for (int j = 0; j < 8; ++j) ss += x[d0][j] * x[d0][j];
    { auto rr = __builtin_amdgcn_permlane32_swap(__float_as_uint(ss), __float_as_uint(ss), false, false); ss = __uint_as_float(rr[0]) + __uint_as_float(rr[1]); }
    const float rstd = 1.0f / sqrtf(ss * (1.f / 128.f) + EPS);
#pragma unroll
    for (int d0 = 0; d0 < 8; ++d0) { const f32x4 g0 = *(const f32x4*)(qg + d0 * 16 + hi * 8), g1 = *(const f32x4*)(qg + d0 * 16 + hi * 8 + 4);
#pragma unroll
      for (int j = 0; j < 4; ++j) { x[d0][j] *= rstd * g0[j]; x[d0][4 + j] *= rstd * g1[j]; } }
    const int pos = qpos0 + wid * QBLK + r32;
#pragma unroll
    for (int hf = 0; hf < 2; ++hf) { const float pv = (float)(hf ? (pos & 63) : (pos >> 6));
#pragma unroll
      for (int e = 0; e < 2; ++e)
#pragma unroll
        for (int j = 0; j < 8; ++j) { const int i = e * 16 + hi * 8 + j; const float a = pv * __builtin_amdgcn_exp2f(-(float)i * (13.287712379549449f / 32.f));
          const float c = __cosf(a), sn = __sinf(a); const float xa = x[hf * 4 + e][j], xb = x[hf * 4 + e + 2][j];
          x[hf * 4 + e][j] = xa * c - xb * sn; x[hf * 4 + e + 2][j] = xb * c + xa * sn; } }
#pragma unroll
    for (int d0 = 0; d0 < 8; ++d0) { u32x4 w;
#pragma unroll
      for (int q = 0; q < 4; ++q) w[q] = cvt_pk_bf16(x[d0][2 * q], x[d0][2 * q + 1]);
      qr[d0] = *reinterpret_cast<const bf16x8*>(&w); } }
  const int sr = tid >> 4, sc = (tid & 15) * 8, vst0 = v_st(sr, sc), vst1 = v_st(32 + sr, sc);
  const int vb0 = (int)(uintptr_t)V_lds + v_rd_base(lane);
  struct { bf16x8 vs0, vs1, ks0, ks1; } sr_[2];
  const unsigned lo0 = (unsigned)(sr * LDK + sc) * 2u;
  constexpr int VDELTA = (ZVA - ZKA) * 2;
#define SLOAD(i, k0) do { const char* kb0_ = (const char*)Kh + (size_t)(k0) * (size_t)(LDK * 2); const char* kb1_ = kb0_ + (size_t)32 * LDK * 2; \
    sr_[i].vs0 = *reinterpret_cast<const bf16x8*>(kb0_ + VDELTA + lo0); sr_[i].vs1 = *reinterpret_cast<const bf16x8*>(kb1_ + VDELTA + lo0); \
    sr_[i].ks0 = *reinterpret_cast<const bf16x8*>(kb0_ + lo0); sr_[i].ks1 = *reinterpret_cast<const bf16x8*>(kb1_ + lo0); } while (0)
#define SWRITE(b, i) do { *(bf16x8*)((char*)V_lds + (b) * SHM_V + vst0) = sr_[i].vs0;          \
    *(bf16x8*)((char*)V_lds + (b) * SHM_V + vst1) = sr_[i].vs1; int kc = sc * 2;               \
    *(bf16x8*)((char*)K_lds + (b) * SHM_K + KSWZ(sr, kc)) = sr_[i].ks0;                       \
    *(bf16x8*)((char*)K_lds + (b) * SHM_K + KSWZ(32 + sr, kc)) = sr_[i].ks1; } while (0)
#define SWAIT() do { asm volatile("s_waitcnt vmcnt(4)" ::: "memory"); } while (0)
#define RESC(a) do { if (__any((a) < 1.f)) { if (hi == 0) al_l[r32] = (a); asm volatile("s_waitcnt lgkmcnt(0)" ::: "memory"); \
    for (int d = 0; d < 4; ++d) for (int r = 0; r < 16; ++r) o[d][r] *= al_l[crow(r, hi)]; } } while (0)
  f32x16 pA0, pA1, pB0, pB1; float mnA, mnB, alA, alB; bf16x8 pa0, pa1, pa2, pa3; const int NT = seq / KVBLK;
  constexpr int SE = 0, SO = 1;
  SLOAD(SE, 0); asm volatile("s_waitcnt vmcnt(0)" ::: "memory"); SWRITE(0, SE); __syncthreads();
  qkt(pA0, pA1, K_lds, qr, r32, hi); partialSM(pA0, pA1, m_reg, mnA, alA);
  SLOAD(SO, KVBLK); if (2 < NT) SLOAD(SE, 2 * KVBLK);
  SWAIT(); SWRITE(1, SO); __syncthreads();
  for (int j = 1; j + 1 < NT; j += 2) {
    SBAR(); qkt(pB0, pB1, (bf16_t*)((char*)K_lds + SHM_K), qr, r32, hi);
    finishSM(pA0, pA1, alA, l_reg, pa0, pa1, pa2, pa3); SBAR();
    SLOAD(SO, (j + 2) * KVBLK); SBAR();
    pv_d0(o, vb0, pa0, pa1, pa2, pa3); partialSM(pB0, pB1, m_reg, mnB, alB);
    __syncthreads(); SWAIT(); SWRITE(0, SE);
    RESC(alB); __syncthreads();
    SBAR(); qkt(pA0, pA1, K_lds, qr, r32, hi);
    finishSM(pB0, pB1, alB, l_reg, pa0, pa1, pa2, pa3); SBAR();
    if (j + 3 < NT) SLOAD(SE, (j + 3) * KVBLK); SBAR();
    pv_d0(o, vb0 + (int)SHM_V, pa0, pa1, pa2, pa3); partialSM(pA0, pA1, m_reg, mnA, alA);
    __syncthreads(); SWAIT(); SWRITE(1, SO);
    RESC(alA); __syncthreads();
  }
  SBAR(); qkt(pB0, pB1, (bf16_t*)((char*)K_lds + SHM_K), qr, r32, hi);
  finishSM(pA0, pA1, alA, l_reg, pa0, pa1, pa2, pa3); SBAR();
  pv_d0(o, vb0, pa0, pa1, pa2, pa3); partialSM(pB0, pB1, m_reg, mnB, alB);
  __syncthreads(); RESC(alB);
  finishSM(pB0, pB1, alB, l_reg, pa0, pa1, pa2, pa3); SBAR();
  pv_d0(o, vb0 + (int)SHM_V, pa0, pa1, pa2, pa3);
  if (hi == 0) li_l[r32] = l_reg; asm volatile("s_waitcnt lgkmcnt(0)" ::: "memory");
  float rli[16];
#pragma unroll
  for (int r = 0; r < 16; ++r) rli[r] = __builtin_amdgcn_rcpf(li_l[crow(r, hi)]);
  unsigned char* Ow = Ob + (long)(wid * QBLK) * 1024;
  { const int jq = r32 & 3; const unsigned selq = 0x0c0c0000u | (unsigned)((4 + jq) << 8) | (unsigned)jq;
#pragma unroll
    for (int g = 0; g < 4; ++g) { unsigned char* rowp = Ow + (long)(8 * g + 4 * hi + jq) * 1024 + (r32 & ~3);
#pragma unroll
      for (int d0 = 0; d0 < 4; ++d0) {
        const unsigned w = q8x4((f32x4){o[d0][4 * g] * rli[4 * g], o[d0][4 * g + 1] * rli[4 * g + 1], o[d0][4 * g + 2] * rli[4 * g + 2], o[d0][4 * g + 3] * rli[4 * g + 3]}, QYA);
        const unsigned t0 = (unsigned)__builtin_amdgcn_mov_dpp((int)w, 0x00, 0xf, 0xf, false), t1 = (unsigned)__builtin_amdgcn_mov_dpp((int)w, 0x55, 0xf, 0xf, false);
        const unsigned t2 = (unsigned)__builtin_amdgcn_mov_dpp((int)w, 0xaa, 0xf, 0xf, false), t3 = (unsigned)__builtin_amdgcn_mov_dpp((int)w, 0xff, 0xf, 0xf, false);
        const unsigned lo = __builtin_amdgcn_perm(t1, t0, selq), hi2 = __builtin_amdgcn_perm(t3, t2, selq);
        *(unsigned*)(rowp + d0 * 32) = lo | (hi2 << 16); } } }
  __syncthreads();
#undef SLOAD
#undef SWRITE
#undef SWAIT
#undef RESC
}
#undef KSWZ
}

__device__ __forceinline__ int hw_lane() { int l; asm volatile("v_mbcnt_lo_u32_b32 %0, -1, 0\n\tv_mbcnt_hi_u32_b32 %0, -1, %0" : "=v"(l)); return l; }
__device__ __forceinline__ int hw_tid(int wave) { return (wave << 6) | hw_lane(); }
__device__ __forceinline__ int opq_idx(int i) { asm volatile("" : "+s"(i)); return i; }
__device__ __forceinline__ size_t opq_off(size_t o) { asm volatile("" : "+s"(o)); return o; }
struct Frame {
    LAS unsigned char* lds; unsigned char* ldsg;
    volatile LAS unsigned* MISC;
    unsigned* ctl;
    int tid, lane, wave, vcu, G;
};

__device__ __forceinline__ void tr_item(const float* __restrict__ W, int ldw, int k0, int n0, bf16_t* __restrict__ WT, int ldt, int drow0, LAS float* scr, int lane) {
#pragma unroll 8
    for (int i = 0; i < 32; ++i) { const int kk = 2 * i + (lane >> 5); scr[kk * 33 + (lane & 31)] = W[(size_t)(k0 + kk) * ldw + n0 + (lane & 31)]; }
    LDS_WAIT();
    const int c = lane & 7;
#pragma unroll
    for (int j = 0; j < 4; ++j) { const int n = (lane >> 3) + 8 * j; const LAS float* s = scr + (8 * c) * 33 + n;
        u32x4 o; o.x = cvt_pk_bf16(s[0 * 33], s[1 * 33]); o.y = cvt_pk_bf16(s[2 * 33], s[3 * 33]); o.z = cvt_pk_bf16(s[4 * 33], s[5 * 33]); o.w = cvt_pk_bf16(s[6 * 33], s[7 * 33]);
        *(u32x4*)(WT + (size_t)(drow0 + n) * ldt + k0 + 8 * c) = o; }
    LDS_WAIT();
}
__device__ __forceinline__ void tr_item8(const float* __restrict__ W, int ldw, int k0, int n0, unsigned char* __restrict__ WT, int ldt, int drow0, float qs, LAS float* scr, int lane) {
    f32x4 t[8];
#pragma unroll
    for (int i = 0; i < 8; ++i) t[i] = *(const f32x4*)(W + (size_t)(k0 + (lane >> 3) + 8 * i) * ldw + n0 + 4 * (lane & 7));
#pragma unroll
    for (int i = 0; i < 8; ++i) *(LAS f32x4*)(scr + ((lane >> 3) + 8 * i) * 36 + 4 * (lane & 7)) = t[i];
    LDS_WAIT();
    const int n = lane >> 1, kh = lane & 1; const LAS float* s = scr + (32 * kh) * 36 + n;
    u32x4 o0, o1;
#pragma unroll
    for (int q = 0; q < 4; ++q) { o0[q] = q8(s[(4 * q) * 36], qs) | (q8(s[(4 * q + 1) * 36], qs) << 8) | (q8(s[(4 * q + 2) * 36], qs) << 16) | (q8(s[(4 * q + 3) * 36], qs) << 24);
        o1[q] = q8(s[(16 + 4 * q) * 36], qs) | (q8(s[(17 + 4 * q) * 36], qs) << 8) | (q8(s[(18 + 4 * q) * 36], qs) << 16) | (q8(s[(19 + 4 * q) * 36], qs) << 24); }
    unsigned char* dst = WT + (size_t)(drow0 + n) * ldt + k0 + 32 * kh;
    *(u32x4*)dst = o0; *(u32x4*)(dst + 16) = o1;
    LDS_WAIT();
}
__device__ __forceinline__ void tr_item8x2(const float* __restrict__ W, int ldw, int k0, int n0, unsigned char* __restrict__ WT, int ldt, int drow0, float qs, LAS float* scr, int lane) {
    f32x4 t[16];
#pragma unroll
    for (int i = 0; i < 16; ++i) t[i] = *(const f32x4*)(W + (size_t)(k0 + (lane >> 3) + 8 * i) * ldw + n0 + 4 * (lane & 7));
    const int n = lane >> 1, kh = lane & 1; const LAS float* s = scr + (32 * kh) * 36 + n;
    u32x4 o[4];
#pragma unroll
    for (int h = 0; h < 2; ++h) {
#pragma unroll
        for (int i = 0; i < 8; ++i) *(LAS f32x4*)(scr + ((lane >> 3) + 8 * i) * 36 + 4 * (lane & 7)) = t[8 * h + i];
        LDS_WAIT();
#pragma unroll
        for (int q = 0; q < 4; ++q) { o[2 * h][q] = q8x4((f32x4){s[(4 * q) * 36], s[(4 * q + 1) * 36], s[(4 * q + 2) * 36], s[(4 * q + 3) * 36]}, qs);
            o[2 * h + 1][q] = q8x4((f32x4){s[(16 + 4 * q) * 36], s[(17 + 4 * q) * 36], s[(18 + 4 * q) * 36], s[(19 + 4 * q) * 36]}, qs); }
        LDS_WAIT(); }
    unsigned char* dst = WT + (size_t)(drow0 + n) * ldt + k0 + 32 * kh;
    *(u32x4*)dst = o[0]; *(u32x4*)(dst + 16) = o[1]; *(u32x4*)(dst + 64) = o[2]; *(u32x4*)(dst + 80) = o[3];
}
struct LayerW { const float *w_in, *w_bm, *w_ba, *w_out, *w_rg, *w_re, *w_eg, *w_eu, *w_ed, *w_pg, *w_pp, *p; };
template <int PART>
__device__ __forceinline__ void convert_weights(Frame& F, const LayerW& L, unsigned char* ws) {
    LAS float* scr = (LAS float*)(F.lds + F.wave * 16384);
    const int gw = F.vcu * NWAVES + F.wave, NGW = F.G * NWAVES, lane = F.lane;
    bf16_t* WIN = (bf16_t*)(ws + opq_off(WS_WIN)); bf16_t* WG = (bf16_t*)(ws + opq_off(WS_WG)); bf16_t* WR = (bf16_t*)(ws + opq_off(WS_WR));
    bf16_t* WBM = (bf16_t*)(ws + opq_off(WS_WBM)); bf16_t* WBA = (bf16_t*)(ws + opq_off(WS_WBA)); bf16_t* WOUT = (bf16_t*)(ws + opq_off(WS_WOUT));
    bf16_t* WPG = (bf16_t*)(ws + opq_off(WS_WPG)); bf16_t* WPP = (bf16_t*)(ws + opq_off(WS_WPP)); bf16_t* WGU = (bf16_t*)(ws + opq_off(WS_WGU)); bf16_t* WD = (bf16_t*)(ws + opq_off(WS_WD));
    constexpr int I_G = 8192, I_U = 8192, I_D = 8192, I_IN = 16 * 305, I_BM = 512, I_BA = 512, I_OUT = 1024, I_PG = 1024, I_PP = 256;
    constexpr int NITEMS = I_G + I_U + I_D + I_IN + I_BM + I_BA + I_OUT + I_PG + I_PP;
    for (int it = gw + (PART == 0 ? I_G + I_U + I_D : 0); it < (PART == 0 ? I_G + I_U + I_D + I_IN : NITEMS - I_IN); it += NGW) {
        int r = (PART == 1 && it >= I_G + I_U + I_D) ? it + I_IN : it;
        if (r < I_G + I_U) { const int which = r >= I_G; if (which) r -= I_G; const int e = r >> 8, q = r & 255, kb = q >> 4, nb = q & 15, n0 = nb * 32;
            tr_item8x2((which ? L.w_eu : L.w_eg) + (size_t)e * DM * DFF, DFF, kb * 128, n0, (unsigned char*)WGU, DM, e * 1024 + (n0 >> 7) * 256 + which * 128 + (n0 & 127), QW_2048, scr, lane); continue; } r -= I_G + I_U;
        if (r < I_D) { const int e = r >> 8, q = r & 255, kb = q >> 6, nb = q & 63;
            tr_item8x2(L.w_ed + (size_t)e * DFF * DM, DM, kb * 128, nb * 32, (unsigned char*)WD, DFF, e * 2048 + nb * 32, QW_512, scr, lane); continue; } r -= I_D;
        if (r < I_IN) { const int kb = r / 305, nb = r % 305, n0 = nb * 32;
            if (n0 >= 4096 && n0 < 4128) tr_item8x2(L.w_in, INW, kb * 128, n0, (unsigned char*)WG, DM, 0, QW_2048, scr, lane);
            else tr_item8x2(L.w_in, INW, kb * 128, n0, (unsigned char*)WIN, DM, n0 < 4096 ? n0 : n0 - 32, QW_2048, scr, lane);
            continue; } r -= I_IN;
        if (r < I_BM) { tr_item8x2(L.w_bm, DM, (r >> 6) * 128, (r & 63) * 32, (unsigned char*)WBM, 1024, (r & 63) * 32, QW_1024, scr, lane); continue; } r -= I_BM;
        if (r < I_BA) { tr_item8x2(L.w_ba, DM, (r >> 6) * 128, (r & 63) * 32, (unsigned char*)WBA, 1024, (r & 63) * 32, QW_1024, scr, lane); continue; } r -= I_BA;
        if (r < I_OUT) { tr_item8x2(L.w_out, DM, (r >> 6) * 128, (r & 63) * 32, (unsigned char*)WOUT, DM, (r & 63) * 32, QW_2048, scr, lane); continue; } r -= I_OUT;
        if (r < I_PG) { tr_item8x2(L.w_pg, DM, (r >> 6) * 128, (r & 63) * 32, (unsigned char*)WPG, DM, (r & 63) * 32, QW_2048, scr, lane); continue; } r -= I_PG;
        tr_item(L.w_pp, DM, (r >> 6) * 64, (r & 63) * 32, WPP, PLE, (r & 63) * 32, scr, lane);
    }
    if (PART == 0) return;
    const int gt = F.vcu * (NWAVES * 64) + F.tid, NGT = F.G * NWAVES * 64;
    for (int idx = gt; idx < 48 * DM; idx += NGT) { const int n = idx >> 11, k = idx & 2047;
        const float v = n < 4 ? L.w_rg[k * 4 + n] : (n < 36 ? L.w_re[k * 32 + (n - 4)] : 0.f);
        ((unsigned char*)WR)[idx] = (unsigned char)q8(v, QW_2048); }
    bf16_t* PB = (bf16_t*)(ws + opq_off(WS_PB));
    for (int idx = gt; idx < T_TOK * PLE / 8; idx += NGT) { const f32x4 a = *(const f32x4*)(L.p + (size_t)idx * 8), b = *(const f32x4*)(L.p + (size_t)idx * 8 + 4);
        *(u32x4*)(PB + (size_t)idx * 8) = pg8::pack8(a, b); }
}

__device__ __forceinline__ void norm_row_bf16(const float* xrow, const float* g, bf16_t* orow, int lane, unsigned char* o8row = nullptr) {
    const f32x4* xr = (const f32x4*)xrow + lane; const f32x4* gr = (const f32x4*)g + lane;
    f32x4 v[8]; float s = 0.f;
#pragma unroll
    for (int j = 0; j < 8; ++j) { v[j] = xr[64 * j]; s += (v[j].x * v[j].x + v[j].y * v[j].y) + (v[j].z * v[j].z + v[j].w * v[j].w); }
    const float rstd = 1.0f / sqrtf(wave_sum(s) * (1.f / DM) + EPS);
    u32x2* o8 = (u32x2*)orow + lane;
#pragma unroll
    for (int j = 0; j < 8; ++j) { const f32x4 gv = gr[64 * j]; const f32x4 y = v[j] * rstd * gv;
        if (orow) { u32x2 w; w.x = cvt_pk_bf16(y.x, y.y); w.y = cvt_pk_bf16(y.z, y.w); o8[64 * j] = w; }
        if (o8row) ((unsigned*)o8row)[lane + 64 * j] = q8x4(y, QA); }
}

template <bool FINAL>
__device__ __forceinline__ void norm_pass(const float* x, float* outf, unsigned char* out8, const float* g, int gw, int NGW, int lane, float* rs_out = nullptr) {
    f32x4 gv[8], a[8], b[8];
#pragma unroll
    for (int j = 0; j < 8; ++j) gv[j] = ((const f32x4*)g)[lane + 64 * j];
#define NP_LOAD(v, m) do { const f32x4* xr_ = (const f32x4*)(x + (size_t)(m) * DM) + lane; _Pragma("unroll") for (int j = 0; j < 8; ++j) v[j] = xr_[64 * j]; } while (0)
#define NP_DO(v, m) do { float s_ = 0.f; _Pragma("unroll") for (int j = 0; j < 8; ++j) s_ += (v[j].x * v[j].x + v[j].y * v[j].y) + (v[j].z * v[j].z + v[j].w * v[j].w); \
        const float rstd_ = 1.0f / sqrtf(wave_sum(s_) * (1.f / DM) + EPS); if (rs_out && lane == 0) rs_out[m] = rstd_; \
        if (FINAL) { f32x4* o_ = (f32x4*)(outf + (size_t)(m) * DM) + lane; _Pragma("unroll") for (int j = 0; j < 8; ++j) o_[64 * j] = v[j] * rstd_ * gv[j]; } \
        else { unsigned* o_ = (unsigned*)(out8 + (size_t)(m) * DM) + lane; _Pragma("unroll") for (int j = 0; j < 8; ++j) o_[64 * j] = q8x4(v[j] * rstd_ * gv[j], QA); } } while (0)
    int m = gw;
    if (m < T_TOK) NP_LOAD(a, m);
    while (m < T_TOK) {
        const int m2 = m + NGW; if (m2 < T_TOK) NP_LOAD(b, m2);
        NP_DO(a, m);
        if (m2 >= T_TOK) break;
        const int m3 = m2 + NGW; if (m3 < T_TOK) NP_LOAD(a, m3);
        NP_DO(b, m2);
        m = m3;
    }
#undef NP_LOAD
#undef NP_DO
}

template <bool FINAL>
__device__ __forceinline__ void norm_pass_b16(const bf16_t* x, float* outf, unsigned char* out8, const float* g, int gw, int NGW, int lane, float* rs_out = nullptr) {
    f32x4 gv[8]; u32x4 a[4], b[4];
#pragma unroll
    for (int j = 0; j < 4; ++j) { gv[2 * j] = ((const f32x4*)g)[2 * (lane + 64 * j)]; gv[2 * j + 1] = ((const f32x4*)g)[2 * (lane + 64 * j) + 1]; }
#define NPB_LOAD(v, m) do { const u32x4* xr_ = (const u32x4*)(x + (size_t)(m) * DM) + lane; _Pragma("unroll") for (int j = 0; j < 4; ++j) v[j] = xr_[64 * j]; } while (0)
#define NPB_DO(v, m) do { f32x4 t_[8]; float s_ = 0.f; _Pragma("unroll") for (int j = 0; j < 4; ++j) pg8::unpack8(v[j], t_[2 * j], t_[2 * j + 1]); \
        _Pragma("unroll") for (int j = 0; j < 8; ++j) s_ += (t_[j].x * t_[j].x + t_[j].y * t_[j].y) + (t_[j].z * t_[j].z + t_[j].w * t_[j].w); \
        const float rstd_ = 1.0f / sqrtf(wave_sum(s_) * (1.f / DM) + EPS); if (rs_out && lane == 0) rs_out[m] = rstd_; \
        if (FINAL) { f32x4* o_ = (f32x4*)(outf + (size_t)(m) * DM) + 2 * lane; _Pragma("unroll") for (int j = 0; j < 4; ++j) { o_[128 * j] = t_[2 * j] * rstd_ * gv[2 * j]; o_[128 * j + 1] = t_[2 * j + 1] * rstd_ * gv[2 * j + 1]; } } \
        else { u32x2* o_ = (u32x2*)(out8 + (size_t)(m) * DM) + lane; _Pragma("unroll") for (int j = 0; j < 4; ++j) { u32x2 q_; q_.x = q8x4(t_[2 * j] * rstd_ * gv[2 * j], QA); q_.y = q8x4(t_[2 * j + 1] * rstd_ * gv[2 * j + 1], QA); o_[64 * j] = q_; } } } while (0)
    int m = gw;
    if (m < T_TOK) NPB_LOAD(a, m);
    while (m < T_TOK) {
        const int m2 = m + NGW; if (m2 < T_TOK) NPB_LOAD(b, m2);
        NPB_DO(a, m);
        if (m2 >= T_TOK) break;
        const int m3 = m2 + NGW; if (m3 < T_TOK) NPB_LOAD(a, m3);
        NPB_DO(b, m2);
        m = m3;
    }
#undef NPB_LOAD
#undef NPB_DO
}

__device__ __forceinline__ void norm_pass_b16w(const bf16_t* x, unsigned char* out8, const float* g, int gw, int NGW, int lane, float* rs_out) {
    f32x4 gv[8]; u32x4 a[4], b[4];
#pragma unroll
    for (int jj = 0; jj < 2; ++jj)
#pragma unroll
        for (int q = 0; q < 4; ++q) gv[4 * jj + q] = ((const f32x4*)g)[4 * (lane + 64 * jj) + q];
#define NPW_LOAD(v, m) do { const u32x4* xr_ = (const u32x4*)(x + (size_t)(m) * DM) + 2 * lane; _Pragma("unroll") for (int jj = 0; jj < 2; ++jj) { v[2 * jj] = xr_[128 * jj]; v[2 * jj + 1] = xr_[128 * jj + 1]; } } while (0)
#define NPW_DO(v, m) do { f32x4 t_[8]; float s_ = 0.f; _Pragma("unroll") for (int j = 0; j < 4; ++j) pg8::unpack8(v[j], t_[2 * j], t_[2 * j + 1]); \
        _Pragma("unroll") for (int j = 0; j < 8; ++j) s_ += (t_[j].x * t_[j].x + t_[j].y * t_[j].y) + (t_[j].z * t_[j].z + t_[j].w * t_[j].w); \
        const float rstd_ = 1.0f / sqrtf(wave_sum(s_) * (1.f / DM) + EPS); if (rs_out && lane == 0) rs_out[m] = rstd_; \
        u32x4* o_ = (u32x4*)(out8 + (size_t)(m) * DM) + lane; \
        _Pragma("unroll") for (int jj = 0; jj < 2; ++jj) { u32x4 q_; _Pragma("unroll") for (int q = 0; q < 4; ++q) q_[q] = q8x4(t_[4 * jj + q] * rstd_ * gv[4 * jj + q], QA); o_[64 * jj] = q_; } } while (0)
    int m = gw;
    if (m < T_TOK) NPW_LOAD(a, m);
    while (m < T_TOK) {
        const int m2 = m + NGW; if (m2 < T_TOK) NPW_LOAD(b, m2);
        NPW_DO(a, m);
        if (m2 >= T_TOK) break;
        const int m3 = m2 + NGW; if (m3 < T_TOK) NPW_LOAD(a, m3);
        NPW_DO(b, m2);
        m = m3;
    }
#undef NPW_LOAD
#undef NPW_DO
}

template <int NT>
__device__ __forceinline__ void skinny16(const bf16_t* __restrict__ A, size_t lda, const bf16_t* __restrict__ Bt, int K, int r0, int fr, int fq, f32x4 (&acc)[NT]) {
    const bf16_t* ap = A + (size_t)(r0 + fr) * lda + 8 * fq; const bf16_t* bp = Bt + (size_t)fr * K + 8 * fq;
#pragma unroll
    for (int n = 0; n < NT; ++n) acc[n] = (f32x4){0.f, 0.f, 0.f, 0.f};
#pragma unroll 4
    for (int ks = 0; ks < K / 32; ++ks) { const bf16x8 a = *(const bf16x8*)(ap + 32 * ks);
#pragma unroll
        for (int n = 0; n < NT; ++n) { const bf16x8 b = *(const bf16x8*)(bp + (size_t)(16 * n) * K + 32 * ks); acc[n] = __builtin_amdgcn_mfma_f32_16x16x32_bf16(a, b, acc[n], 0, 0, 0); } }
}

template <int NT>
__device__ __forceinline__ void skinny16_i8(const unsigned char* __restrict__ A, size_t lda, const unsigned char* __restrict__ Bt, int K, int r0, int fr, int fq, float deq, f32x4 (&acc)[NT]) {
    const unsigned char* ap = A + (size_t)(r0 + fr) * lda + 16 * fq; const unsigned char* bp = Bt + (size_t)fr * K + 16 * fq;
    i32x4 ia[NT];
#pragma unroll
    for (int n = 0; n < NT; ++n) ia[n] = (i32x4){0, 0, 0, 0};
#pragma unroll 4
    for (int ks = 0; ks < K / 64; ++ks) { const i32x4 a = *(const i32x4*)(ap + 64 * ks);
#pragma unroll
        for (int n = 0; n < NT; ++n) { const i32x4 b = *(const i32x4*)(bp + (size_t)(16 * n) * K + 64 * ks); ia[n] = __builtin_amdgcn_mfma_i32_16x16x64_i8(a, b, ia[n], 0, 0, 0); } }
#pragma unroll
    for (int n = 0; n < NT; ++n) acc[n] = __builtin_convertvector(ia[n], f32x4) * deq;
}

__device__ __forceinline__ void qk_prepass(Frame& F, bf16_t* Z, const float* kg) {
    const int gw = F.vcu * NWAVES + F.wave, NGW = F.G * NWAVES, lane = F.lane;
    const int half = lane >> 5, isb = (lane >> 4) & 1, i0 = 2 * (lane & 15);
    const float f0 = __builtin_amdgcn_exp2f(-(float)i0 * (13.287712379549449f / 32.f)), f1 = __builtin_amdgcn_exp2f(-(float)(i0 + 1) * (13.287712379549449f / 32.f));
    const f32x2 gk = *(const f32x2*)(kg + 2 * lane);
    for (int tok = gw; tok < T_TOK; tok += NGW) {
        const int pos = tok & (SEQ - 1);
        unsigned* p = (unsigned*)(Z + (size_t)tok * LDZ + ZQA) + lane;
        unsigned w[2];
#pragma unroll
        for (int s = 0; s < 2; ++s) w[s] = p[64 * (8 + s)];
        const float pv = (float)(half ? (pos & 63) : (pos >> 6));
        const float a0 = pv * f0, a1 = pv * f1;
        const float c0 = __cosf(a0), s0 = __sinf(a0), c1 = __cosf(a1), s1 = __sinf(a1);
        const float sg0 = isb ? s0 : -s0, sg1 = isb ? s1 : -s1;
#pragma unroll
        for (int s = 0; s < 2; ++s) {
            float x0 = bf_lo(w[s]), x1 = bf_hi(w[s]);
            const float ss = wave_sum(x0 * x0 + x1 * x1);
            const float rstd = 1.0f / sqrtf(ss * (1.f / 128.f) + EPS);
            x0 = x0 * rstd * gk.x; x1 = x1 * rstd * gk.y;
            const float q0 = xor_shfl<16>(x0), q1 = xor_shfl<16>(x1);
            p[64 * (8 + s)] = cvt_pk_bf16(x0 * c0 + q0 * sg0, x1 * c1 + q1 * sg1);
        }
    }
}

__device__ __forceinline__ void ym_combine(Frame& F, bf16_t* Z, const bf16_t* HFW, const bf16_t* HBW, const float* g) {
    const int gw = F.vcu * NWAVES + F.wave, NGW = F.G * NWAVES, lane = F.lane;
    f32x4 gv[4];
#pragma unroll
    for (int q = 0; q < 4; ++q) gv[q] = *(const f32x4*)(g + 16 * lane + 4 * q) * (1.0f / 255.0f);
    u32x4 fa[2], ba[2], fb[2], bb[2]; u32x4 sa, sb;
#define YM_TOK(i) ((gw + (i) * NGW) < T_TOK ? (gw + (i) * NGW) : (T_TOK - 1))
#define YM_LOAD(f, b, s, tok) do { const size_t o_ = (size_t)(tok) * 1024 + 16 * lane; const unsigned char* zp_ = (const unsigned char*)(Z + (size_t)(tok) * LDZ + ZOM) + 16 * lane; \
        s = *(const u32x4*)zp_; _Pragma("unroll") for (int q = 0; q < 2; ++q) { f[q] = *(const u32x4*)(HFW + o_ + 8 * q); b[q] = *(const u32x4*)(HBW + o_ + 8 * q); } } while (0)
#define YM_DO(f, b, s, tok) do { float v[16]; \
        _Pragma("unroll") for (int q = 0; q < 2; ++q) { f32x4 a0, a1, b0, b1; pg8::unpack8(f[q], a0, a1); pg8::unpack8(b[q], b0, b1); \
            _Pragma("unroll") for (int i = 0; i < 4; ++i) { v[8 * q + i] = a0[i] + b0[i]; v[8 * q + 4 + i] = a1[i] + b1[i]; } } \
        float ss = 0.f; _Pragma("unroll") for (int i = 0; i < 16; ++i) ss += v[i] * v[i]; \
        ss += xor_shfl<1>(ss); ss += xor_shfl<2>(ss); ss += xor_shfl<4>(ss); \
        const float rstd = 1.0f / sqrtf(ss * (1.f / 128.f) + EPS); \
        u32x4 o; \
        _Pragma("unroll") for (int q = 0; q < 2; ++q) { const f32x4 s0 = u8x4_f(s[2 * q]), s1 = u8x4_f(s[2 * q + 1]); f32x4 y0, y1; \
            _Pragma("unroll") for (int i = 0; i < 4; ++i) { y0[i] = v[8 * q + i] * rstd * gv[2 * q][i] * s0[i]; y1[i] = v[8 * q + 4 + i] * rstd * gv[2 * q + 1][i] * s1[i]; } \
            o[2 * q] = q8x4(y0, QA); o[2 * q + 1] = q8x4(y1, QA); } \
        *(u32x4*)((unsigned char*)(Z + (size_t)(tok) * LDZ + ZQM) + 16 * lane) = o; } while (0)
    const int ntok = (T_TOK - gw + NGW - 1) / NGW;
    YM_LOAD(fa, ba, sa, YM_TOK(0));
    for (int i = 0; i < ntok; i += 2) {
        YM_LOAD(fb, bb, sb, YM_TOK(i + 1));
        YM_DO(fa, ba, sa, YM_TOK(i));
        YM_LOAD(fa, ba, sa, YM_TOK(i + 2));
        if (i + 1 < ntok) YM_DO(fb, bb, sb, YM_TOK(i + 1));
    }
#undef YM_TOK
#undef YM_LOAD
#undef YM_DO
}

__device__ __forceinline__ unsigned offb(unsigned row, unsigned ch) { return 256u * row + 16u * (ch ^ (((row & 3u) << 2) | ((row >> 2) & 3u))); }
template <int OFF> __device__ __forceinline__ s16x4 tr_rd(unsigned addr) { s16x4 r; asm volatile("ds_read_b64_tr_b16 %0, %1 offset:%2" : "=&v"(r) : "v"(addr), "i"(OFF) : "memory"); return r; }
__device__ __forceinline__ float wave_scan_add(float v, int lane) {
#pragma unroll
    for (int o = 1; o < 64; o <<= 1) { const float t = lane_get(v, lane - o); if (lane >= o) v += t; }
    return v;
}
__device__ __forceinline__ float wave_scan_max(float v, int lane) {
#pragma unroll
    for (int o = 1; o < 64; o <<= 1) { const float t = lane_get(v, lane - o); if (lane >= o) v = fmaxf(v, t); }
    return v;
}
#define MFMA16(a, b, c) __builtin_amdgcn_mfma_f32_16x16x32_bf16(a, b, c, 0, 0, 0)
constexpr int ML_KT = 0, ML_VT = 32768, ML_ST = 65536, ML_CT = 98304, ML_AR = 135168;
template <int KS> __device__ __forceinline__ void mlstm_b_ks(LAS unsigned char* lds, f32x4 (&aI)[9], const unsigned (&tav)[8][2], unsigned rowoff, int w, const bf16x8& onesf, const bf16x8& Qf, float g) {
    {
        s16x4 vl[8], vh[8];
#pragma unroll
        for (int cc = 0; cc < 8; ++cc) { vl[cc] = tr_rd<8192 * KS>(tav[cc][0]); vh[cc] = tr_rd<8192 * KS>(tav[cc][1]); }
        const bf16x8 Sf = *(const LAS bf16x8*)(lds + ML_ST + 4096 * w + rowoff);
        LDS_WAIT(); __builtin_amdgcn_sched_barrier(0);
#pragma unroll
        for (int cc = 0; cc < 8; ++cc) { const bf16x8 Vf = (bf16x8){vl[cc][0], vl[cc][1], vl[cc][2], vl[cc][3], vh[cc][0], vh[cc][1], vh[cc][2], vh[cc][3]}; aI[cc] = MFMA16(Vf, Sf, aI[cc]); }
        aI[8] = MFMA16(onesf, Sf, aI[8]);
    }
    {
        bf16x8 Cf[9];
#pragma unroll
        for (int cc = 0; cc < 9; ++cc) Cf[cc] = *(const LAS bf16x8*)(lds + ML_CT + 4096 * cc + rowoff);
        u32x4 qw = *reinterpret_cast<const u32x4*>(&Qf);
        qw.x = cvt_pk_bf16(bf_lo(qw.x) * g, bf_hi(qw.x) * g); qw.y = cvt_pk_bf16(bf_lo(qw.y) * g, bf_hi(qw.y) * g); qw.z = cvt_pk_bf16(bf_lo(qw.z) * g, bf_hi(qw.z) * g); qw.w = cvt_pk_bf16(bf_lo(qw.w) * g, bf_hi(qw.w) * g);
        const bf16x8 Qg = *reinterpret_cast<const bf16x8*>(&qw);
        LDS_WAIT(); __builtin_amdgcn_sched_barrier(0);
#pragma unroll
        for (int cc = 0; cc < 9; ++cc) aI[cc] = MFMA16(Cf[cc], Qg, aI[cc]);
    }
}
template <int KS> __device__ __forceinline__ void mlstm_c_ks(LAS unsigned char* lds, f32x4 (&accC)[9], const unsigned (&tav)[8][2], unsigned tak0, unsigned tak1, const bf16x8& onesf, int fq) {
    s16x4 vl[8], vh[8];
    const s16x4 kl = tr_rd<8192 * KS>(tak0), kh = tr_rd<8192 * KS>(tak1);
#pragma unroll
    for (int cc = 0; cc < 8; ++cc) { vl[cc] = tr_rd<8192 * KS>(tav[cc][0]); vh[cc] = tr_rd<8192 * KS>(tav[cc][1]); }
    const LAS float* WK = (const LAS float*)(lds + ML_AR) + 640;
    const f32x4 wk0 = *(const LAS f32x4*)(WK + 32 * KS + 8 * fq), wk1 = *(const LAS f32x4*)(WK + 32 * KS + 8 * fq + 4);
    LDS_WAIT(); __builtin_amdgcn_sched_barrier(0);
    u32x4 kw;
    kw.x = cvt_pk_bf16(bf2f((unsigned short)kl[0]) * wk0[0], bf2f((unsigned short)kl[1]) * wk0[1]); kw.y = cvt_pk_bf16(bf2f((unsigned short)kl[2]) * wk0[2], bf2f((unsigned short)kl[3]) * wk0[3]);
    kw.z = cvt_pk_bf16(bf2f((unsigned short)kh[0]) * wk1[0], bf2f((unsigned short)kh[1]) * wk1[1]); kw.w = cvt_pk_bf16(bf2f((unsigned short)kh[2]) * wk1[2], bf2f((unsigned short)kh[3]) * wk1[3]);
    const bf16x8 Kf = *reinterpret_cast<bf16x8*>(&kw);
#pragma unroll
    for (int cc = 0; cc < 8; ++cc) { const bf16x8 Vf = (bf16x8){vl[cc][0], vl[cc][1], vl[cc][2], vl[cc][3], vh[cc][0], vh[cc][1], vh[cc][2], vh[cc][3]}; accC[cc] = MFMA16(Kf, Vf, accC[cc]); }
    accC[8] = MFMA16(Kf, onesf, accC[8]);
}
__device__ __forceinline__ void gld16(u32x4& r, const void* p) { asm volatile("global_load_dwordx4 %0, %1, off" : "=&v"(r) : "v"(p) : "memory"); }
__device__ __forceinline__ void gld4(float& r, const void* p) { asm volatile("global_load_dword %0, %1, off" : "=&v"(r) : "v"(p) : "memory"); }
__device__ __forceinline__ void mlstm_seq(Frame& F, const bf16_t* __restrict__ Z, const float* __restrict__ GATES, const float* __restrict__ gb, bf16_t* __restrict__ HOUT, int b, int h, int dir) {
    constexpr int KT = ML_KT, VT = ML_VT, ST = ML_ST, CT = ML_CT, AR = ML_AR;
    LAS unsigned char* lds = F.lds;
    const unsigned ldsb = (unsigned)(uintptr_t)lds;
    LAS float* LI = (LAS float*)(lds + AR); LAS float* LF = LI + 128; LAS float* CS = LI + 256; LAS float* MS = LI + 384; LAS float* BS = LI + 512; LAS float* WK = LI + 640; LAS float* SC = LI + 768;
    const int tid = F.tid, w = F.wave;
    const float bias_i = gb[dir * 8 + h], bias_f = gb[16 + dir * 8 + h];
    __syncthreads();
    { unsigned z_ = 0u; asm volatile("" : "+v"(z_)); for (int i = tid; i < 36864 / 16; i += 512) *(LAS u32x4*)(lds + CT + 16 * i) = (u32x4){z_, z_, z_, z_}; }
    f32x4 accC[9];
#pragma unroll
    for (int c = 0; c < 9; ++c) accC[c] = (f32x4){0.f, 0.f, 0.f, 0.f};
    float m_state = 0.f;
    const size_t tokb = (size_t)b * SEQ;
    u32x4 pk_[4], pv_[4], pq_[4]; float pli_ = 0.f, pfp_ = 0.f;
#define ML_PF_ISSUE(cn) do { const int l_ = hw_lane(), t_ = (w << 6) | l_; \
        if (t_ < 128) { const int pos = dir ? (SEQ - 1 - (128 * (cn) + t_)) : (128 * (cn) + t_); const float* gp = GATES + (tokb + pos) * 32; gld4(pli_, gp + dir * 8 + h); gld4(pfp_, gp + 16 + dir * 8 + h); } \
        _Pragma("unroll") for (int p = 0; p < 4; ++p) { const int idx = t_ + 512 * p, row = idx >> 4, ch = idx & 15; const int pos = dir ? (SEQ - 1 - (128 * (cn) + row)) : (128 * (cn) + row); \
            const bf16_t* src = Z + (tokb + pos) * LDZ + h * 128 + ch * 8; gld16(pk_[p], src + ZKM); gld16(pv_[p], src + ZVM); } \
        { const int row = 16 * w + (l_ & 15); const int pos = dir ? (SEQ - 1 - (128 * (cn) + row)) : (128 * (cn) + row); const bf16_t* src = Z + (tokb + pos) * LDZ + ZQM + h * 128 + 8 * (l_ >> 4); \
          _Pragma("unroll") for (int ks = 0; ks < 4; ++ks) gld16(pq_[ks], src + 32 * ks); } } while (0)
#define ML_PF_WAIT() asm volatile("s_waitcnt vmcnt(0)" : "+v"(pk_[0]), "+v"(pk_[1]), "+v"(pk_[2]), "+v"(pk_[3]), "+v"(pv_[0]), "+v"(pv_[1]), "+v"(pv_[2]), "+v"(pv_[3]), "+v"(pq_[0]), "+v"(pq_[1]), "+v"(pq_[2]), "+v"(pq_[3]), "+v"(pli_), "+v"(pfp_) : : "memory")
#pragma unroll
    for (int p = 0; p < 4; ++p) { pk_[p] = (u32x4){0u, 0u, 0u, 0u}; pv_[p] = pk_[p]; pq_[p] = pk_[p]; }
    ML_PF_ISSUE(0);
    for (int c = 0; c < 16; ++c) {
        const int lane = hw_lane();
        const int fr = lane & 15, fq = lane >> 4;
        unsigned rowoff[4];
#pragma unroll
        for (int s = 0; s < 4; ++s) rowoff[s] = 256u * fr + 64u * ((unsigned)s ^ (fr & 3u)) + 16u * ((unsigned)fq ^ ((fr >> 2) & 3u));
        unsigned trb[2], trx[2];
        { const unsigned q = fr >> 2, p = fr & 3;
#pragma unroll
          for (int t = 0; t < 2; ++t) { const unsigned x = (q << 2) | ((2u * fq + t) & 3u); trx[t] = x >> 1; trb[t] = ldsb + 256u * (8u * fq + 4u * t + q) + 16u * ((p >> 1) ^ (x & 1u)) + 8u * (p & 1u); } }
        unsigned tav[8][2];
#pragma unroll
        for (int cc = 0; cc < 8; ++cc)
#pragma unroll
            for (int t = 0; t < 2; ++t) tav[cc][t] = trb[t] + VT + 32u * ((unsigned)cc ^ trx[t]);
        const unsigned tak0 = trb[0] + KT + 32u * ((unsigned)w ^ trx[0]), tak1 = trb[1] + KT + 32u * ((unsigned)w ^ trx[1]);
        bf16x8 onesf;
#pragma unroll
        for (int i = 0; i < 8; ++i) onesf[i] = (fr == 0) ? (short)0x3F80 : (short)0;
        ML_PF_WAIT();
        if (tid < 128) { const float li = pli_ + bias_i, fp = pfp_ + bias_f;
            LI[tid] = li; LF[tid] = fminf(fp, 0.f) - __logf(1.0f + __expf(-fabsf(fp))); }
#pragma unroll
        for (int p = 0; p < 4; ++p) { const int idx = tid + 512 * p, row = idx >> 4, ch = idx & 15;
            *(LAS u32x4*)(lds + KT + offb(row, ch)) = pk_[p]; *(LAS u32x4*)(lds + VT + offb(row, ch)) = pv_[p]; }
        bf16x8 Qf[4];
#pragma unroll
        for (int ks = 0; ks < 4; ++ks) Qf[ks] = *reinterpret_cast<const bf16x8*>(&pq_[ks]);
        asm volatile("" ::: "memory");
        if (c + 1 < 16) ML_PF_ISSUE(c + 1);
        __syncthreads();
        if (w == 0) {
            const float x0 = LF[2 * lane], x1 = LF[2 * lane + 1], i0 = LI[2 * lane], i1 = LI[2 * lane + 1];
            const float s = x0 + x1, incl = wave_scan_add(s, lane), b0 = (incl - s) + x0, b1 = incl;
            const float c0 = i0 - b0, c1 = i1 - b1;
            const float im = wave_scan_max(fmaxf(c0, c1), lane); float em = lane_get(im, lane - 1); if (lane == 0) em = -3.0e38f;
            const float M0 = fmaxf(fmaxf(em, c0), m_state), M1 = fmaxf(im, m_state);
            const float Mlast = __int_as_float(__builtin_amdgcn_readlane(__float_as_int(M1), 63)), blast = __int_as_float(__builtin_amdgcn_readlane(__float_as_int(b1), 63));
            BS[2 * lane] = b0; BS[2 * lane + 1] = b1; CS[2 * lane] = c0; CS[2 * lane + 1] = c1; MS[2 * lane] = M0; MS[2 * lane + 1] = M1;
            WK[2 * lane] = __expf(c0 - Mlast); WK[2 * lane + 1] = __expf(c1 - Mlast);
            if (lane == 0) { SC[0] = blast; SC[1] = Mlast; }
        }
        __syncthreads();
        const float blast = SC[0], Mlast = SC[1];
        const float decay = __expf(m_state - Mlast);
        const float Mt = MS[16 * w + fr], bt = BS[16 * w + fr];
#pragma unroll
        for (int j = 0; j < 8; ++j) {
            u32x2 pk = (u32x2){0u, 0u};
            if (j <= w) {
                f32x4 a = (f32x4){0.f, 0.f, 0.f, 0.f};
#pragma unroll
                for (int ks = 0; ks < 4; ++ks) { const bf16x8 Af = *(const LAS bf16x8*)(lds + KT + 4096 * j + rowoff[ks]); a = MFMA16(Af, Qf[ks], a); }
                const f32x4 cs = *(const LAS f32x4*)(CS + 16 * j + 4 * fq);
                float v[4];
#pragma unroll
                for (int r = 0; r < 4; ++r) { const int s = 16 * j + 4 * fq + r, t = 16 * w + fr; v[r] = (s <= t) ? a[r] * __expf(cs[r] - Mt) : 0.f; }
                pk.x = cvt_pk_bf16(v[0], v[1]); pk.y = cvt_pk_bf16(v[2], v[3]);
            }
            *(LAS u32x2*)(lds + ST + offb(16 * w + fr, 2 * j + (fq >> 1)) + 8 * (fq & 1)) = pk;
        }
        LDS_WAIT();
        const float g = __expf(m_state - Mt);
        f32x4 aI[9];
#pragma unroll
        for (int cc = 0; cc < 9; ++cc) aI[cc] = (f32x4){0.f, 0.f, 0.f, 0.f};
        mlstm_b_ks<0>(lds, aI, tav, rowoff[0], w, onesf, Qf[0], g); mlstm_b_ks<1>(lds, aI, tav, rowoff[1], w, onesf, Qf[1], g);
        mlstm_b_ks<2>(lds, aI, tav, rowoff[2], w, onesf, Qf[2], g); mlstm_b_ks<3>(lds, aI, tav, rowoff[3], w, onesf, Qf[3], g);
        {
            const float den = lane_get(aI[8][0], fr);
            const float inv = 1.0f / fmaxf(fabsf(den), __expf(-(bt + Mt)));
            const int row = 16 * w + fr; const int pos = dir ? (SEQ - 1 - (128 * c + row)) : (128 * c + row);
            bf16_t* op = HOUT + (tokb + pos) * 1024 + h * 128 + 16 * (fq & 1) + 8 * (fq >> 1);
#pragma unroll
            for (int cp = 0; cp < 4; ++cp) { const f32x4 h0 = aI[2 * cp] * inv, h1 = aI[2 * cp + 1] * inv;
                const unsigned a0 = cvt_pk_bf16(h0[0], h0[1]), a1 = cvt_pk_bf16(h0[2], h0[3]), b0 = cvt_pk_bf16(h1[0], h1[1]), b1 = cvt_pk_bf16(h1[2], h1[3]);
                const auto r0 = __builtin_amdgcn_permlane16_swap(a0, b0, false, false); const auto r1 = __builtin_amdgcn_permlane16_swap(a1, b1, false, false);
                *(u32x4*)(op + 32 * cp) = (u32x4){r0[0], r1[0], r0[1], r1[1]}; }
        }
#pragma unroll
        for (int cc = 0; cc < 9; ++cc) accC[cc] = accC[cc] * decay;
        mlstm_c_ks<0>(lds, accC, tav, tak0, tak1, onesf, fq); mlstm_c_ks<1>(lds, accC, tav, tak0, tak1, onesf, fq);
        mlstm_c_ks<2>(lds, accC, tav, tak0, tak1, onesf, fq); mlstm_c_ks<3>(lds, accC, tav, tak0, tak1, onesf, fq);
        m_state = blast + Mlast;
        __syncthreads();
        float one_ = 1.0f; asm volatile("" : "+v"(one_));
#pragma unroll
        for (int cc = 0; cc < 9; ++cc) { const f32x4 ct = accC[cc] * one_; u32x2 o; o.x = cvt_pk_bf16(ct[0], ct[1]); o.y = cvt_pk_bf16(ct[2], ct[3]);
            *(LAS u32x2*)(lds + CT + offb(16 * cc + fr, 2 * w + (fq >> 1)) + 8 * (fq & 1)) = o; }
    }
    __syncthreads();
}

__device__ __forceinline__ void router_phase(Frame& F, const unsigned char* HB, const float* part, const float* rin, float* listf, const unsigned char* WR, const float* b_rg, const float* b_re, unsigned* gcnt, int* LIST, int* TOKE, int* TOKP, float* TOKW) {
    const int tid = F.tid, lane = F.lane, w = F.wave, fr = lane & 15, fq = lane >> 4;
    volatile LAS unsigned* LCNT = F.MISC + 96; volatile LAS unsigned* LBASE = F.MISC + 128;
    LAS float* LG = (LAS float*)(F.lds + w * 3072);
    for (int blk = F.vcu; blk < T_TOK / 128; blk += F.G) {
        const int r0 = blk * 128 + 16 * w;
        f32x4 acc[3];
        skinny16_i8<3>(HB, DM, WR, DM, r0, fr, fq, 1.0f / (QA2 * QW_2048), acc);
        float f_;
        { float ps = 0.f;
#pragma unroll
          for (int j = 0; j < 8; ++j) ps += part[(size_t)(fq * 8 + j) * T_TOK + r0 + fr];
          ps += xor_shfl<16>(ps);
          { auto rr = __builtin_amdgcn_permlane32_swap(__float_as_uint(ps), __float_as_uint(ps), false, false); ps = __uint_as_float(rr[0]) + __uint_as_float(rr[1]); }
          f_ = (1.0f / sqrtf(ps * (1.f / DM) + EPS)) / rin[r0 + fr];
        }
#pragma unroll
        for (int n = 0; n < 3; ++n)
#pragma unroll
            for (int r = 0; r < 4; ++r) LG[(4 * fq + r) * 48 + 16 * n + fr] = acc[n][r];
        if (tid < 32) LCNT[tid] = 0u;
        LDS_WAIT();
        __syncthreads();
        int e0 = 0, e1 = 0; float w0 = 0.f, w1 = 0.f; unsigned pl0 = 0, pl1 = 0;
        if (lane < 16) {
            const LAS float* lg = LG + lane * 48;
            float gl[4]; int gi = 0; float gm = -3.0e38f;
#pragma unroll
            for (int j = 0; j < 4; ++j) { gl[j] = lg[j] * f_ + b_rg[j]; if (gl[j] > gm) { gm = gl[j]; gi = j; } }
            float gs = 0.f;
#pragma unroll
            for (int j = 0; j < 4; ++j) gs += __expf(gl[j] - gm);
            const float gp = 1.0f / gs;
            float v0 = -3.0e38f, v1 = -3.0e38f; int j0 = 0, j1 = 0;
            for (int j = 0; j < 8; ++j) { const float v = lg[4 + 8 * gi + j] * f_ + b_re[8 * gi + j];
                if (v > v0) { v1 = v0; j1 = j0; v0 = v; j0 = j; } else if (v > v1) { v1 = v; j1 = j; } }
            const float x = __expf(v1 - v0);
            w0 = gp / (1.0f + x); w1 = gp * x / (1.0f + x);
            e0 = gi * 8 + j0; e1 = gi * 8 + j1;
            pl0 = __hip_atomic_fetch_add((LAS unsigned*)(LCNT + e0), 1u, __ATOMIC_RELAXED, __HIP_MEMORY_SCOPE_WORKGROUP);
            pl1 = __hip_atomic_fetch_add((LAS unsigned*)(LCNT + e1), 1u, __ATOMIC_RELAXED, __HIP_MEMORY_SCOPE_WORKGROUP);
        }
        __syncthreads();
        if (tid < 32) { const unsigned n = LCNT[tid]; LBASE[tid] = n ? __hip_atomic_fetch_add(gcnt + tid, n, RLX_AGENT) : 0u; }
        __syncthreads();
        if (lane < 16) {
            const int tok = r0 + lane; const int p0 = (int)(LBASE[e0] + pl0), p1 = (int)(LBASE[e1] + pl1);
            __hip_atomic_store(LIST + (size_t)e0 * LISTCAP + p0, tok, RLX_AGENT); __hip_atomic_store(LIST + (size_t)e1 * LISTCAP + p1, tok, RLX_AGENT);
            listf[(size_t)e0 * LISTCAP + p0] = f_; listf[(size_t)e1 * LISTCAP + p1] = f_;
            TOKE[2 * tok] = e0; TOKE[2 * tok + 1] = e1; TOKP[2 * tok] = p0; TOKP[2 * tok + 1] = p1; TOKW[2 * tok] = w0; TOKW[2 * tok + 1] = w1;
        }
        __syncthreads();
    }
}
__device__ __forceinline__ void moe_table(Frame& F, const unsigned* gcnt) {
    volatile LAS int* MCNT = (volatile LAS int*)(F.MISC + 16); volatile LAS int* MCUM = (volatile LAS int*)(F.MISC + 48);
    __syncthreads();
    if (F.tid < 32) MCNT[F.tid] = (int)__hip_atomic_load(gcnt + F.tid, RLX_AGENT);
    __syncthreads();
    if (F.tid == 0) { int s = 0; for (int e = 0; e < NEXP; ++e) { MCUM[e] = s; s += (MCNT[e] + 255) >> 8; } MCUM[NEXP] = s; }
    __syncthreads();
}

struct Args { const float* in[23]; float* out; unsigned char* ws; int ph_lo, ph_hi; };
constexpr int PH_PER_LAYER = 12, N_PHASES = DEPTH * PH_PER_LAYER + 1;

__global__ void __launch_bounds__(NWAVES * 64, 2) fwd_kernel(Args args) {
    extern __shared__ __attribute__((aligned(16))) unsigned char lds[];
    Frame F;
    F.lds = (LAS unsigned char*)lds; F.ldsg = lds;
    F.MISC = (volatile LAS unsigned*)(F.lds + MISC_OFF);
    F.tid = threadIdx.x; F.lane = F.tid & 63; F.wave = __builtin_amdgcn_readfirstlane(F.tid >> 6);
    F.G = gridDim.x; { const int bx = blockIdx.x; F.vcu = (bx % 8) * (F.G / 8) + bx / 8; }
    unsigned char* ws = args.ws;
    F.ctl = (unsigned*)(ws + WS_CTL);
    for (int u = F.tid; u < 256; u += NWAVES * 64) F.MISC[u] = 0u;
    __syncthreads();
#if MK_PER_PHASE
    XcdBarrier bar; bar.bar = F.ctl + CW_BAR; bar.x = 0; bar.st = nullptr;
#define GRID_BAR() do { } while (0)
#else
    XcdBarrier bar = xcd_barrier_post(F.ctl + CW_BAR, F.MISC + 0);
#define GRID_BAR() xcd_barrier(bar)
#endif
    const int lo = args.ph_lo, hi = args.ph_hi; (void)lo; (void)hi;
#if MK_PER_PHASE
#define IN(k) (lo <= (k) && (k) < hi)
#else
#define IN(k) true
#endif
#define SEAM(k) do { if (IN((k) + 1)) GRID_BAR(); } while (0)
#define PHASE_BEGIN() do { const int t_ = hw_tid(wave0); F.tid = t_; F.lane = t_ & 63; F.wave = __builtin_amdgcn_readfirstlane(t_ >> 6); \
        int b_ = blockIdx.x; asm volatile("" : "+s"(b_)); bx = b_; F.vcu = (b_ % 8) * (G / 8) + b_ / 8; gw = F.vcu * NWAVES + F.wave; \
        unsigned lb_ = 0; asm volatile("" : "+s"(lb_)); F.ldsg = lds + lb_; F.lds = (LAS unsigned char*)lds + lb_; F.MISC = (volatile LAS unsigned*)(F.lds + MISC_OFF); \
        F.ctl = (unsigned*)(args.ws + opq_off(WS_CTL)); ws = args.ws + opq_off(0); } while (0)
#define INP(i) (args.in[opq_idx(i)])
#define Z_ ((bf16_t*)(args.ws + opq_off(WS_Z)))
#define HB_ ((bf16_t*)(args.ws + opq_off(WS_HB)))
#define HFW_ ((bf16_t*)(args.ws + opq_off(WS_HFW)))
#define HBW_ ((bf16_t*)(args.ws + opq_off(WS_HBW)))
#define HID_ ((bf16_t*)(args.ws + opq_off(WS_HID)))
#define YS_ ((bf16_t*)(args.ws + opq_off(WS_YS)))
#define PP_ ((bf16_t*)(args.ws + opq_off(WS_PP)))
#define PB_ ((bf16_t*)(args.ws + opq_off(WS_PB)))
#define GATES_ ((float*)(args.ws + opq_off(WS_GATES)))
#define TOKE_ ((int*)(args.ws + opq_off(WS_TOKE)))
#define TOKP_ ((int*)(args.ws + opq_off(WS_TOKP)))
#define TOKW_ ((float*)(args.ws + opq_off(WS_TOKW)))
#define LIST_ ((int*)(args.ws + opq_off(WS_LIST)))
#define X_ (args.out)
#define XB_ ((bf16_t*)args.out)
#define XF_ ((bf16_t*)(args.ws + opq_off(WS_XF)))
    const int G = F.G, NGW = G * NWAVES; int bx = (int)blockIdx.x, gw = F.vcu * NWAVES + F.wave; const int wave0 = F.wave;

    for (int layer = 0; layer < DEPTH; ++layer) {
        const int P = layer * PH_PER_LAYER;

        if (IN(P + 0)) {
            PHASE_BEGIN();
            LayerW L;
            L.w_in = INP(3) + (size_t)layer * DM * INW; L.w_bm = INP(8) + (size_t)layer * 1024 * DM; L.w_ba = INP(9) + (size_t)layer * 1024 * DM; L.w_out = INP(10) + (size_t)layer * DM * DM;
            L.w_rg = INP(12) + (size_t)layer * DM * 4; L.w_re = INP(14) + (size_t)layer * DM * 32;
            L.w_eg = INP(16) + (size_t)layer * NEXP * DM * DFF; L.w_eu = INP(17) + (size_t)layer * NEXP * DM * DFF; L.w_ed = INP(18) + (size_t)layer * NEXP * DFF * DM;
            L.w_pg = INP(20) + (size_t)layer * DM * DM; L.w_pp = INP(21) + (size_t)layer * PLE * DM; L.p = INP(1) + (size_t)layer * T_TOK * PLE;
            if (layer == 0) convert_weights<0>(F, L, args.ws);
            const float* g1 = INP(2) + layer * DM;
            if (layer == 0) norm_pass<false>(INP(0), nullptr, args.ws + opq_off(WS_HB8), g1, gw, NGW, F.lane, (float*)(args.ws + opq_off(WS_RIN)));
            else norm_pass_b16w(XB_, args.ws + opq_off(WS_HB8), g1, gw, NGW, F.lane, (float*)(args.ws + opq_off(WS_RIN)));
            SEAM(P + 0);
        }
        if (IN(P + 1)) {
            PHASE_BEGIN();
            { const int fr = F.lane & 15, fq = F.lane >> 4;
              for (int task = gw; task < T_TOK / 16; task += NGW) { f32x4 acc[2]; skinny16_i8<2>(args.ws + opq_off(WS_HB8), DM, args.ws + opq_off(WS_WG), DM, task * 16, fr, fq, 1.0f / (QA * QW_2048), acc);
#pragma unroll
                  for (int n = 0; n < 2; ++n)
#pragma unroll
                      for (int r = 0; r < 4; ++r) GATES_[(size_t)(task * 16 + 4 * fq + r) * 32 + 16 * n + fr] = acc[n][r]; } }
            pg8::DenseSched S; S.init(args.ws + opq_off(WS_HB8), DM / 2, args.ws + opq_off(WS_WIN), DM / 2, T_TOK, LDZ, G, bx);
            pg8::EpiZ E{Z_, 1.0f / (QA * QW_2048)};
            pg8::gemm_phase<pg8::EpiZ, pg8::DenseSched, true>(F.lds, DM / 2, S, E, F.wave);
            SEAM(P + 1);
        }
        if (IN(P + 2)) {
            PHASE_BEGIN();
            qk_prepass(F, Z_, INP(7) + layer * 128);
            for (int seq = F.vcu; seq < 256; seq += G) { const int b = seq >> 4, h = (seq >> 1) & 7, dir = seq & 1;
                mlstm_seq(F, Z_, GATES_, INP(4) + layer * 32, dir ? HBW_ : HFW_, b, h, dir); }
            SEAM(P + 2);
        }
        if (IN(P + 3)) {
            PHASE_BEGIN();
            const int x8 = bx & 7, j = bx >> 3, per = G >> 3;
            const int cslot = j % 5; bool cdone = false;
#define P3_CONVERT() do { PHASE_BEGIN(); LayerW L;     \
                L.w_in = INP(3) + (size_t)layer * DM * INW; L.w_bm = INP(8) + (size_t)layer * 1024 * DM; L.w_ba = INP(9) + (size_t)layer * 1024 * DM; L.w_out = INP(10) + (size_t)layer * DM * DM; \
                L.w_rg = INP(12) + (size_t)layer * DM * 4; L.w_re = INP(14) + (size_t)layer * DM * 32; \
                L.w_eg = INP(16) + (size_t)layer * NEXP * DM * DFF; L.w_eu = INP(17) + (size_t)layer * NEXP * DM * DFF; L.w_ed = INP(18) + (size_t)layer * NEXP * DFF * DM; \
                L.w_pg = INP(20) + (size_t)layer * DM * DM; L.w_pp = INP(21) + (size_t)layer * PLE * DM; L.p = INP(1) + (size_t)layer * T_TOK * PLE; \
                ym_combine(F, Z_, HFW_, HBW_, INP(5) + layer * 1024); __syncthreads(); \
                convert_weights<1>(F, L, args.ws); \
                if (layer + 1 < DEPTH) { L.w_in = INP(3) + (size_t)(layer + 1) * DM * INW; convert_weights<0>(F, L, args.ws); } } while (0)
            for (int i = 0; ; ++i) {
                if (i == cslot) { P3_CONVERT(); cdone = true; __syncthreads(); }
                int unit;
                if ((G & 7) == 0) { const int jj = i * per + j; if (jj >= 128) break; unit = x8 * 128 + jj; } else { unit = i * G + bx; if (unit >= 1024) break; }
                const int qb = unit & 7, hh = (unit >> 3) & 7, b = unit >> 6, kvh = hh >> 2;
                const size_t rowq = (size_t)b * SEQ + qb * 256;
                const int tu_ = hw_tid(F.wave);
                att::attn_dense_body(Z_ + rowq * LDZ + ZQA + hh * 128, Z_ + (size_t)b * SEQ * LDZ + ZKA + kvh * 128, Z_ + (size_t)b * SEQ * LDZ + ZVA + kvh * 128, args.ws + opq_off(WS_YA8) + rowq * 1024 + hh * 128, SEQ, (char*)F.ldsg, tu_, INP(6) + layer * 128, qb * 256);
            }
            if (!cdone) { __syncthreads(); P3_CONVERT(); }
#undef P3_CONVERT
            SEAM(P + 3);
        }
        if (IN(P + 4)) {
            PHASE_BEGIN();
            { pg8::DenseSched S; S.init(Z_ + ZQM, LDZ, args.ws + opq_off(WS_WBM), 512, T_TOK, DM, G, bx); pg8::EpiMerge<false> E{Z_, (unsigned char*)HB_, nullptr, 1.0f / (QA * QW_1024 * 255.0f)}; pg8::gemm_phase<pg8::EpiMerge<false>, pg8::DenseSched, true>(F.lds, 512, S, E, F.wave); }
            { pg8::DenseSched S; S.init(args.ws + opq_off(WS_YA8), 512, args.ws + opq_off(WS_WBA), 512, T_TOK, DM, G, bx); pg8::EpiMerge<true> E{Z_, (unsigned char*)HB_, args.ws + opq_off(WS_HB8), 1.0f / (QYA * QW_1024 * 255.0f)}; pg8::gemm_phase<pg8::EpiMerge<true>, pg8::DenseSched, true>(F.lds, 512, S, E, F.wave); }
            SEAM(P + 4);
        }
        if (IN(P + 5)) {
            PHASE_BEGIN();
            pg8::DenseSched S; S.init(args.ws + opq_off(WS_HB8), DM / 2, args.ws + opq_off(WS_WOUT), DM / 2, T_TOK, DM, G, bx); pg8::EpiResidQ E{layer == 0 ? INP(0) : nullptr, XB_, XB_, (unsigned char*)HFW_, INP(11) + layer * DM, (const float*)(args.ws + opq_off(WS_RIN)), (float*)(args.ws + opq_off(WS_PART)), 1.0f / (QM * QW_2048)};
            pg8::gemm_phase<pg8::EpiResidQ, pg8::DenseSched, true>(F.lds, DM / 2, S, E, F.wave);
            SEAM(P + 5);
        }
        if (IN(P + 7)) {
            PHASE_BEGIN();
            router_phase(F, (const unsigned char*)HFW_, (const float*)(args.ws + opq_off(WS_PART)), (const float*)(args.ws + opq_off(WS_RIN)), (float*)(args.ws + opq_off(WS_LISTF)), args.ws + opq_off(WS_WR), INP(13) + layer * 4, INP(15) + layer * 32, (F.ctl + CW_CNT + 64 * layer), LIST_, TOKE_, TOKP_, TOKW_);
            SEAM(P + 7);
        }
        if (IN(P + 8)) {
            PHASE_BEGIN();
            moe_table(F, (F.ctl + CW_CNT + 64 * layer));
            pg8::MoeUpSched S; S.A = (const char*)HFW_; S.Bt = (const char*)(args.ws + opq_off(WS_WGU)); S.ldaB = DM; S.ldbB = DM; S.list = LIST_;
            S.mcnt = (const volatile LAS int*)(F.MISC + 16); S.mcum = (const volatile LAS int*)(F.MISC + 48); S.nwg = S.mcum[NEXP] * 4; S.G = G; S.c = bx;
            pg8::EpiSwiGLU E{(unsigned char*)HID_, (const float*)(args.ws + opq_off(WS_LISTF)), (const volatile LAS int*)(F.MISC + 16), 1.0f / (QA2 * QW_2048)};
            pg8::gemm_phase<pg8::EpiSwiGLU, pg8::MoeUpSched, true>(F.lds, DM / 2, S, E, F.wave);
            SEAM(P + 8);
        }
        if (IN(P + 9)) {
            PHASE_BEGIN();
#if MK_PER_PHASE
            moe_table(F, (F.ctl + CW_CNT + 64 * layer));
#endif
            pg8::MoeDownSched S; S.A = (const char*)HID_; S.Bt = (const char*)(args.ws + opq_off(WS_WD)); S.ldaB = DFF; S.ldbB = DFF;
            S.mcum = (const volatile LAS int*)(F.MISC + 48); S.nwg = S.mcum[NEXP] * 8; S.G = G; S.c = bx;
            pg8::EpiI8 E{(unsigned char*)YS_, DM, QY / (QH * QW_512)};
            pg8::gemm_phase<pg8::EpiI8, pg8::MoeDownSched, true>(F.lds, opq_idx(DFF / 2), S, E, F.wave);
            SEAM(P + 9);
        }
        if (IN(P + 10)) {
            PHASE_BEGIN();
#if MK_PER_PHASE
            moe_table(F, (F.ctl + CW_CNT + 64 * layer));
#endif
            { const volatile LAS int* MCUM = (const volatile LAS int*)(F.MISC + 48); const float* gpl = INP(19) + layer * DM; const int lane = F.lane;
              const int* te = TOKE_; const int* tp = TOKP_; const float* tw = TOKW_; const unsigned char* ys = (const unsigned char*)YS_; unsigned char* hb8 = args.ws + opq_off(WS_HB8);
              f32x4 gv[8];
#pragma unroll
              for (int jj = 0; jj < 2; ++jj)
#pragma unroll
                  for (int q = 0; q < 4; ++q) gv[4 * jj + q] = ((const f32x4*)gpl)[4 * (lane + 64 * jj) + q];
              int m = gw; int ne0 = 0, ne1 = 0, np0 = 0, np1 = 0; float nw0 = 0.f, nw1 = 0.f;
              if (m < T_TOK) { ne0 = te[2 * m]; ne1 = te[2 * m + 1]; np0 = tp[2 * m]; np1 = tp[2 * m + 1]; nw0 = tw[2 * m]; nw1 = tw[2 * m + 1]; }
              for (; m < T_TOK; m += NGW) {
                  const size_t s0 = (size_t)MCUM[ne0] * 256 + np0, s1 = (size_t)MCUM[ne1] * 256 + np1;
                  const float w0 = nw0 * (1.0f / QY), w1 = nw1 * (1.0f / QY);
                  { const int mn = m + NGW; if (mn < T_TOK) { ne0 = te[2 * mn]; ne1 = te[2 * mn + 1]; np0 = tp[2 * mn]; np1 = tp[2 * mn + 1]; nw0 = tw[2 * mn]; nw1 = tw[2 * mn + 1]; } }
                  u32x4* xr = (u32x4*)(XB_ + (size_t)m * DM) + 2 * lane; const u32x4* y0 = (const u32x4*)(ys + s0 * DM) + lane; const u32x4* y1 = (const u32x4*)(ys + s1 * DM) + lane;
                  f32x4 v[8]; float s = 0.f;
#pragma unroll
                  for (int jj = 0; jj < 2; ++jj) { const u32x4 aw = y0[64 * jj], bw = y1[64 * jj]; const u32x4 xa = xr[128 * jj], xb = xr[128 * jj + 1]; f32x4 t[4]; pg8::unpack8(xa, t[0], t[1]); pg8::unpack8(xb, t[2], t[3]);
#pragma unroll
                      for (int q = 0; q < 4; ++q) { t[q] = t[q] + s8x4_f(aw[q]) * w0 + s8x4_f(bw[q]) * w1; v[4 * jj + q] = t[q];
                          s += (t[q].x * t[q].x + t[q].y * t[q].y) + (t[q].z * t[q].z + t[q].w * t[q].w); }
                      xr[128 * jj] = pg8::pack8(t[0], t[1]); xr[128 * jj + 1] = pg8::pack8(t[2], t[3]); }
                  const float rstd = 1.0f / sqrtf(wave_sum(s) * (1.f / DM) + EPS);
                  u32x4* q8p = (u32x4*)(hb8 + (size_t)m * DM) + lane;
#pragma unroll
                  for (int jj = 0; jj < 2; ++jj) { u32x4 q_;
#pragma unroll
                      for (int q = 0; q < 4; ++q) q_[q] = q8x4(v[4 * jj + q] * rstd * gv[4 * jj + q], QA);
                      q8p[64 * jj] = q_; }
              } }
            __syncthreads();
            pg8::DenseSched S; S.init(PB_, PLE, args.ws + opq_off(WS_WPP), PLE, T_TOK, DM, G, bx); pg8::EpiI8 E{(unsigned char*)PP_, DM, QP};
            pg8::gemm_phase<pg8::EpiI8, pg8::DenseSched>(F.lds, PLE, S, E, F.wave);
            SEAM(P + 10);
        }
        if (IN(P + 11)) {
            PHASE_BEGIN();
            pg8::DenseSched S; S.init(args.ws + opq_off(WS_HB8), DM / 2, args.ws + opq_off(WS_WPG), DM / 2, T_TOK, DM, G, bx); pg8::EpiPle E{XB_, layer == DEPTH - 1 ? XF_ : XB_, (const unsigned char*)PP_, 1.0f / (QA * QW_2048)};
            pg8::gemm_phase<pg8::EpiPle, pg8::DenseSched, true>(F.lds, DM / 2, S, E, F.wave);
            SEAM(P + 11);
        }
    }
    if (IN(DEPTH * PH_PER_LAYER)) {
        PHASE_BEGIN();
        norm_pass_b16<true>(XF_, X_, nullptr, INP(22), gw, NGW, F.lane);
    }
#undef IN
#undef SEAM
}

extern "C" void kernel_launch(void* const* d_in, const int* in_sizes, int n_in, void* d_out, int out_size, void* d_ws, size_t ws_size, hipStream_t stream) {
    static int grid = 0;
    if (grid == 0) {
        if (n_in != 23 || in_sizes[0] != T_TOK * DM || out_size != T_TOK * DM || ws_size < WS_END2) {
            fprintf(stderr, "kernel_launch: shape/workspace mismatch: n_in %d in0 %d out %d ws %zu (need %zu)\n", n_in, n_in > 0 ? in_sizes[0] : -1, out_size, ws_size, (size_t)WS_END2); grid = -1; return; }
        int dev = 0, cus = 0, per_cu = 0;
        if (hipGetDevice(&dev) != hipSuccess || hipDeviceGetAttribute(&cus, hipDeviceAttributeMultiprocessorCount, dev) != hipSuccess) { grid = -1; return; }
        if (hipFuncSetAttribute((const void*)fwd_kernel, hipFuncAttributeMaxDynamicSharedMemorySize, LDS_BYTES) != hipSuccess) { fprintf(stderr, "kernel_launch: hipFuncSetAttribute failed\n"); grid = -1; return; }
        if (hipOccupancyMaxActiveBlocksPerMultiprocessor(&per_cu, (const void*)fwd_kernel, NWAVES * 64, LDS_BYTES) != hipSuccess || per_cu < 1) fprintf(stderr, "kernel_launch: occupancy query reports %d\n", per_cu);
        (void)hipGetLastError();
        grid = cus - (cus % 8);
    }
    if (grid < 0) return;
    if (hipMemsetAsync((char*)d_ws + WS_CTL, 0, CTL_ZERO_BYTES, stream) != hipSuccess) return;
    Args a{};
    for (int i = 0; i < 23; ++i) a.in[i] = (const float*)d_in[i];
    a.out = (float*)d_out; a.ws = (unsigned char*)d_ws;
#if MK_PER_PHASE
    for (int p = 0; p < N_PHASES; ++p) { a.ph_lo = p; a.ph_hi = p + 1; hipLaunchKernelGGL(fwd_kernel, dim3(grid), dim3(NWAVES * 64), LDS_BYTES, stream, a); }
#else
    a.ph_lo = 0; a.ph_hi = N_PHASES;
    hipLaunchKernelGGL(fwd_kernel, dim3(grid), dim3(NWAVES * 64), LDS_BYTES, stream, a);
#endif
    const hipError_t le = hipPeekAtLastError();
    if (le != hipSuccess) fprintf(stderr, "kernel_launch: launch failed: %s\n", hipGetErrorName(le));
}
```

```cpp
#include <hip/hip_runtime.h>
#include <cstdio>
#include <cstdint>
#include <type_traits>

#ifndef MK_PER_PHASE
#define MK_PER_PHASE 0
#endif

#define LAS __attribute__((address_space(3)))
#define GAS __attribute__((address_space(1)))
typedef unsigned short bf16_t;
typedef short bf16x8 __attribute__((ext_vector_type(8)));
typedef short s16x4 __attribute__((ext_vector_type(4)));
typedef float f32x4 __attribute__((ext_vector_type(4)));
typedef float f32x2 __attribute__((ext_vector_type(2)));
typedef float f32x16 __attribute__((ext_vector_type(16)));
typedef unsigned u32x4 __attribute__((ext_vector_type(4)));
typedef unsigned u32x2 __attribute__((ext_vector_type(2)));
typedef int i32x4 __attribute__((ext_vector_type(4)));

constexpr int T_TOK = 32768, DM = 2048, SEQ = 2048, NBATCH = 16, DEPTH = 2;
constexpr int INW = 9760, LDZ = 9728;
constexpr int ZQM = 0, ZKM = 1024, ZVM = 2048, ZOM = 3072, ZQA = 4096, ZKA = 5120, ZVA = 5376, ZGM = 5632, ZGA = 7680;
constexpr int NEXP = 32, DFF = 512, PLE = 256, LISTCAP = 32768;
constexpr float EPS = 1e-6f;
constexpr float QA = 25.4f, QW_2048 = 127.0f * 45.254833995939045f / 4.0f, QW_1024 = 127.0f * 32.0f / 4.0f, QM = 63.5f, QA2 = 24.0f, QH = 127.0f / 8.0f,
    QY = 127.0f / 4.0f, QP = 127.0f / 4.5f, QYA = 254.0f,
    QW_512 = 127.0f * 22.627416997969522f / 4.0f;

constexpr size_t MiB = 1u << 20;
constexpr size_t WS_CTL = 0, CTL_ZERO_BYTES = 1 * MiB;
constexpr size_t WS_GATES = 1 * MiB;
constexpr size_t WS_TOKE = 5 * MiB;
constexpr size_t WS_TOKP = WS_TOKE + 256 * 1024;
constexpr size_t WS_TOKW = WS_TOKP + 256 * 1024;
constexpr size_t WS_LIST = 6 * MiB;
constexpr size_t WS_PB = 10 * MiB;
constexpr size_t WS_WIN = 26 * MiB;
constexpr size_t WS_WG = 64 * MiB;
constexpr size_t WS_WR = WS_WG + 256 * 1024;
constexpr size_t WS_WBM = 65 * MiB, WS_WBA = 69 * MiB, WS_WOUT = 73 * MiB, WS_WPG = 81 * MiB, WS_WPP = 89 * MiB;
constexpr size_t WS_WGU = 90 * MiB;
constexpr size_t WS_WD = 218 * MiB;
constexpr size_t WS_HB = 282 * MiB;
constexpr size_t WS_HFW = 410 * MiB, WS_HBW = 474 * MiB;
constexpr size_t WS_Z = 538 * MiB;
constexpr size_t WS_HID = WS_Z;
constexpr size_t WS_YS = WS_Z + 72 * MiB;
constexpr size_t WS_XF = WS_Z + 224 * MiB;
constexpr size_t WS_PP = WS_Z + 360 * MiB;
constexpr size_t WS_END = WS_Z + 608 * MiB;
constexpr size_t WS_HB8 = WS_END;
constexpr size_t WS_YA8 = WS_HB8 + 64 * MiB;
constexpr size_t WS_PART = WS_YA8 + 32 * MiB;
constexpr size_t WS_FROW = WS_PART + 4 * MiB;
constexpr size_t WS_RIN = WS_FROW + 1 * MiB;
constexpr size_t WS_LISTF = WS_RIN + 1 * MiB;
constexpr size_t WS_END2 = WS_LISTF + 4 * MiB;
constexpr int CW_BAR = 4096;
constexpr int CW_CNT = 16384;

constexpr int SCR_BYTES = 139264;
constexpr int GQ_OFF = 131072 + 4096;
constexpr int MISC_OFF = SCR_BYTES;
constexpr int LDS_BYTES = SCR_BYTES + 1024;
constexpr int NWAVES = 8;

#define RLX_AGENT __ATOMIC_RELAXED, __HIP_MEMORY_SCOPE_AGENT
#define LDS_WAIT() asm volatile("s_waitcnt lgkmcnt(0)" ::: "memory")
#define VM_WAIT() asm volatile("s_waitcnt vmcnt(0)" ::: "memory")

typedef __bf16 bf16x2n_t __attribute__((ext_vector_type(2))); typedef float f32x2n_t __attribute__((ext_vector_type(2)));
__device__ __forceinline__ unsigned cvt_pk_bf16(float lo, float hi) { const f32x2n_t v = {lo, hi}; return __builtin_bit_cast(unsigned, __builtin_convertvector(v, bf16x2n_t)); }
__device__ __forceinline__ float bf_lo(unsigned w) { return __uint_as_float(w << 16); }
__device__ __forceinline__ float bf_hi(unsigned w) { return __uint_as_float(w & 0xffff0000u); }
__device__ __forceinline__ float bf2f(unsigned short b) { return __uint_as_float(((unsigned)b) << 16); }
__device__ __forceinline__ unsigned q8(float v, float s) { return (unsigned)(int)rintf(fminf(fmaxf(v * s, -127.f), 127.f)) & 0xffu; }
typedef short s16x2_t __attribute__((ext_vector_type(2)));
__device__ __forceinline__ unsigned q8x4(const f32x4& y, float s) {
    constexpr float K = 32768.0f / (128.0f * 32767.0f); const float c1 = s * K, c0 = 0.5f * K;
    const s16x2_t p = __builtin_amdgcn_cvt_pknorm_i16(fmaf(y.x, c1, c0), fmaf(y.y, c1, c0)), q = __builtin_amdgcn_cvt_pknorm_i16(fmaf(y.z, c1, c0), fmaf(y.w, c1, c0));
    return __builtin_amdgcn_perm(__builtin_bit_cast(unsigned, q), __builtin_bit_cast(unsigned, p), 0x07050301u);
}
__device__ __forceinline__ unsigned qu8x4(const f32x4& y) { return (unsigned)(y.x * 255.f + 0.5f) | ((unsigned)(y.y * 255.f + 0.5f) << 8) | ((unsigned)(y.z * 255.f + 0.5f) << 16) | ((unsigned)(y.w * 255.f + 0.5f) << 24); }
__device__ __forceinline__ f32x4 u8x4_f(unsigned w) { return (f32x4){(float)(w & 0xffu), (float)((w >> 8) & 0xffu), (float)((w >> 16) & 0xffu), (float)(w >> 24)}; }
__device__ __forceinline__ f32x4 s8x4_f(unsigned w) { const int a = (int)w; return (f32x4){(float)((a << 24) >> 24), (float)((a << 16) >> 24), (float)((a << 8) >> 24), (float)(a >> 24)}; }
__device__ __forceinline__ float sigmoidf_(float x) { return __builtin_amdgcn_rcpf(1.0f + __expf(-x)); }
template <int M> __device__ __forceinline__ float xor_shfl(float v) { static_assert(M >= 1 && M <= 16, "mask"); return __int_as_float(__builtin_amdgcn_ds_swizzle(__float_as_int(v), (M << 10) | 0x1f)); }
__device__ __forceinline__ float wave_sum(float v) {
    v += xor_shfl<1>(v); v += xor_shfl<2>(v); v += xor_shfl<4>(v); v += xor_shfl<8>(v); v += xor_shfl<16>(v);
    auto rr = __builtin_amdgcn_permlane32_swap(__float_as_uint(v), __float_as_uint(v), false, false);
    return __uint_as_float(rr[0]) + __uint_as_float(rr[1]);
}
__device__ __forceinline__ float lane_get(float v, int src_lane) { return __int_as_float(__builtin_amdgcn_ds_bpermute(src_lane << 2, __float_as_int(v))); }

#define XB_TMO      128
#define XB_XCNT(j)  (256  + 64 * (j))
#define XB_XSUB(j)  (1280 + 64 * (j))
#define XB_XGEN(j)  (2304 + 64 * (j))
#define XB_TOP      3328
#define XB_TOPGEN   3392
#define XCD_BAR_WORDS 3456
#define XB_SPIN_CAP (1u << 18)
__device__ __forceinline__ unsigned xb_ld(unsigned* p)              { return __hip_atomic_load(p, __ATOMIC_RELAXED, __HIP_MEMORY_SCOPE_AGENT); }
__device__ __forceinline__ unsigned xb_add(unsigned* p, unsigned v) { return __hip_atomic_fetch_add(p, v, __ATOMIC_RELAXED, __HIP_MEMORY_SCOPE_AGENT); }
__device__ __forceinline__ unsigned xb_xcc_id() { return (unsigned)__builtin_amdgcn_s_getreg((3 << 11) | 20) & 0xFu; }
#define XB_SPIN(cond, bar) do { unsigned _sp = 0; while (cond) { __builtin_amdgcn_s_sleep(1); \
    if ((++_sp & 255u) == 0u) { if (xb_ld(&(bar)[XB_TMO])) break; if (_sp > XB_SPIN_CAP) { atomicAdd(&(bar)[XB_TMO], 1u); break; } } } } while (0)
struct XcdBarrier { unsigned* bar; unsigned x; volatile LAS unsigned* st; };
__device__ __forceinline__ XcdBarrier xcd_barrier_post(unsigned* bar, volatile LAS unsigned* st) {
    XcdBarrier b; b.bar = bar; b.x = xb_xcc_id(); b.st = st;
    if (threadIdx.x == 0) (void)xb_add(&bar[XB_XCNT(b.x)], 1u);
    return b;
}
__device__ __forceinline__ void xcd_barrier_complete(unsigned* bar, unsigned x, unsigned& nloc, unsigned& nx) {
    const unsigned G = gridDim.x * gridDim.y * gridDim.z;
    unsigned sum, cnt, mine, sp = 0u;
    for (;;) {
        sum = 0u; cnt = 0u; mine = 0u;
#pragma unroll
        for (unsigned j = 0; j < 16; ++j) { const unsigned c = xb_ld(&bar[XB_XCNT(j)]); sum += c; cnt += (c > 0u) ? 1u : 0u; mine = (j == x) ? c : mine; }
        if (sum == G) break;
        __builtin_amdgcn_s_sleep(1);
        if ((++sp & 255u) == 0u) { if (xb_ld(&bar[XB_TMO])) break; if (sp > XB_SPIN_CAP) { atomicAdd(&bar[XB_TMO], 1u); break; } }
    }
    nloc = mine > 0u ? mine : 1u; nx = cnt > 0u ? cnt : 1u;
}
__device__ __forceinline__ void xcd_barrier(const XcdBarrier& b) {
    asm volatile("s_waitcnt vmcnt(0)" ::: "memory");
    __syncthreads();
    if (threadIdx.x == 0) {
        unsigned* bar = b.bar;
        __builtin_amdgcn_s_waitcnt(0);
        unsigned nloc = b.st[0], nx = b.st[1];
        if (nloc == 0u) { xcd_barrier_complete(bar, b.x, nloc, nx); b.st[0] = nloc; b.st[1] = nx; }
        const unsigned old = xb_add(&bar[XB_XSUB(b.x)], 1u);
        const unsigned gen = old / nloc;
        if (old + 1u == (gen + 1u) * nloc) {
            __builtin_amdgcn_fence(__ATOMIC_RELEASE, "agent");
            asm volatile("s_waitcnt vmcnt(0)" ::: "memory");
            const unsigned og = xb_add(&bar[XB_TOP], 1u);
            const unsigned tg = og / nx;
            if (og + 1u == (tg + 1u) * nx) xb_add(&bar[XB_TOPGEN], 1u);
            else XB_SPIN(xb_ld(&bar[XB_TOPGEN]) == tg, bar);
            __builtin_amdgcn_fence(__ATOMIC_ACQUIRE, "agent");
            xb_add(&bar[XB_XGEN(b.x)], 1u);
            asm volatile("s_waitcnt vmcnt(0)" ::: "memory");
        } else {
            XB_SPIN(xb_ld(&bar[XB_XGEN(b.x)]) == gen, bar);
            __builtin_amdgcn_fence(__ATOMIC_ACQUIRE, "agent");
            asm volatile("s_waitcnt vmcnt(0)" ::: "memory");
        }
    }
    __syncthreads();
}

namespace pg8 {
__device__ __forceinline__ int pg8_lane() { int l; asm volatile("v_mbcnt_lo_u32_b32 %0, -1, 0\n\tv_mbcnt_hi_u32_b32 %0, -1, %0" : "=v"(l)); return l; }
constexpr int BM = 256, BK = 64, HALF = 128, HTB = HALF * BK * 2, STAGE_BYTES = 8 * HTB, NXCD = 8, WGM = 4;
__host__ __device__ __forceinline__ int lds_byte(int r, int c) { const int st = (r >> 4) * 2 + (c >> 5), rr = r & 15, cc = c & 31, ob = rr * 64 + cc * 2; return st * 1024 + (ob ^ (((ob >> 9) & 1) << 5)); }
__host__ __device__ __forceinline__ void stage_rc(int b, int& R, int& C) { const int st = b / 1024, sb = b % 1024, swz = sb ^ (((sb >> 9) & 1) << 5); R = (st >> 1) * 16 + swz / 64; C = (st & 1) * 32 + (swz % 64) / 2; }
__host__ __device__ __forceinline__ int sgq(int fq) { return ((fq & 1) << 1) | (fq >> 1); }
__host__ __device__ __forceinline__ int perm32(int rho) { const int n = rho >> 4, i = rho & 15; return 8 * sgq(i >> 2) + 4 * n + (i & 3); }
struct Unit { int pm, pn, e, aux; };
__device__ __forceinline__ int xcd_remap(int L, int nwg) { const int q = nwg / NXCD, r = nwg % NXCD, xcd = L % NXCD, off = L / NXCD; return (xcd < r ? xcd * (q + 1) : r * (q + 1) + (xcd - r) * q) + off; }

struct DenseSched {
    static constexpr bool GATHER = false;
    const char* A; const char* Bt; unsigned ldaB, ldbB; int nM, nN, nwg, G, c;
    __device__ __forceinline__ void init(const void* A_, int lda, const void* Bt_, int K, int M, int N, int G_, int c_) { A = (const char*)A_; Bt = (const char*)Bt_; ldaB = (unsigned)lda * 2u; ldbB = (unsigned)K * 2u; nM = M / BM; nN = N / BM; nwg = nM * nN; G = G_; c = c_; }
    __device__ __forceinline__ bool next(int i, Unit& u) const {
        const long L = (long)i * G + c; if (L >= nwg) return false;
        const int wgid = xcd_remap((int)L, nwg);
        const int nig = WGM * nN, gid = wgid / nig, fm = gid * WGM, gsz = (nM - fm) < WGM ? (nM - fm) : WGM;
        u.pm = fm + ((wgid % nig) % gsz); u.pn = (wgid % nig) / gsz; u.e = 0; u.aux = 0; return true;
    }
    __device__ __forceinline__ const char* a_tile(const Unit& u) const { return A + (size_t)u.pm * BM * ldaB; }
    __device__ __forceinline__ const char* b_tile(const Unit& u) const { return Bt + (size_t)u.pn * BM * ldbB; }
    __device__ __forceinline__ unsigned row_index(const Unit&, int) const { return 0u; }
};
struct MoeUpSched {
    static constexpr bool GATHER = true;
    const char* A; const char* Bt; unsigned ldaB, ldbB; const int* list; const volatile LAS int* mcnt; const volatile LAS int* mcum; int nwg, G, c;
    __device__ __forceinline__ bool next(int i, Unit& u) const {
        const long L = (long)i * G + c; if (L >= nwg) return false;
        const int wgid = xcd_remap((int)L, nwg), RB = wgid >> 2; int e = 0;
        for (int j = 1; j < NEXP; ++j) e = (mcum[j] <= RB) ? j : e;
        e = __builtin_amdgcn_readfirstlane(e); u.pm = RB; u.pn = wgid & 3; u.e = e; u.aux = __builtin_amdgcn_readfirstlane(RB - mcum[e]); return true;
    }
    __device__ __forceinline__ const char* a_tile(const Unit&) const { return A; }
    __device__ __forceinline__ const char* b_tile(const Unit& u) const { return Bt + ((size_t)u.e * 1024 + (size_t)u.pn * BM) * ldbB; }
    __device__ __forceinline__ unsigned row_index(const Unit& u, int r) const { const int pos = u.aux * BM + r; return pos < mcnt[u.e] ? (unsigned)list[(size_t)u.e * LISTCAP + pos] : 0u; }
};
struct MoeDownSched {
    static constexpr bool GATHER = false;
    const char* A; const char* Bt; unsigned ldaB, ldbB; const volatile LAS int* mcum; int nwg, G, c;
    __device__ __forceinline__ bool next(int i, Unit& u) const {
        const long L = (long)i * G + c; if (L >= nwg) return false;
        const int wgid = xcd_remap((int)L, nwg), RB = wgid >> 3; int e = 0;
        for (int j = 1; j < NEXP; ++j) e = (mcum[j] <= RB) ? j : e;
        e = __builtin_amdgcn_readfirstlane(e); u.pm = RB; u.pn = wgid & 7; u.e = e; u.aux = __builtin_amdgcn_readfirstlane(RB - mcum[e]); return true;
    }
    __device__ __forceinline__ const char* a_tile(const Unit& u) const { return A + (size_t)u.pm * BM * ldaB; }
    __device__ __forceinline__ const char* b_tile(const Unit& u) const { return Bt + ((size_t)u.e * 2048 + (size_t)u.pn * BM) * ldbB; }
    __device__ __forceinline__ unsigned row_index(const Unit&, int) const { return 0u; }
};

__device__ __forceinline__ u32x4 pack8(const f32x4& v0, const f32x4& v1) { u32x4 w; w.x = cvt_pk_bf16(v0[0], v0[1]); w.y = cvt_pk_bf16(v0[2], v0[3]); w.z = cvt_pk_bf16(v1[0], v1[1]); w.w = cvt_pk_bf16(v1[2], v1[3]); return w; }
__device__ __forceinline__ u32x4 widen16(const u32x2& p0, const u32x2& p1) {
    const auto rx = __builtin_amdgcn_permlane32_swap(p0.x, p1.x, false, false); const auto ry = __builtin_amdgcn_permlane32_swap(p0.y, p1.y, false, false);
    return (u32x4){rx[0], ry[0], rx[1], ry[1]}; }
__device__ __forceinline__ void narrow16(const u32x4& w, u32x2& p0, u32x2& p1) {
    const auto rx = __builtin_amdgcn_permlane32_swap(w.x, w.z, false, false); const auto ry = __builtin_amdgcn_permlane32_swap(w.y, w.w, false, false);
    p0.x = rx[0]; p0.y = ry[0]; p1.x = rx[1]; p1.y = ry[1]; }
__device__ __forceinline__ void unpack8(const u32x4& w, f32x4& v0, f32x4& v1) { v0 = (f32x4){bf_lo(w.x), bf_hi(w.x), bf_lo(w.y), bf_hi(w.y)}; v1 = (f32x4){bf_lo(w.z), bf_hi(w.z), bf_lo(w.w), bf_hi(w.w)}; }
__device__ __forceinline__ f32x4 sig4s(const f32x4& v, float k) { return (f32x4){__builtin_amdgcn_rcpf(1.0f + __builtin_amdgcn_exp2f(v[0] * k)), __builtin_amdgcn_rcpf(1.0f + __builtin_amdgcn_exp2f(v[1] * k)), __builtin_amdgcn_rcpf(1.0f + __builtin_amdgcn_exp2f(v[2] * k)), __builtin_amdgcn_rcpf(1.0f + __builtin_amdgcn_exp2f(v[3] * k))}; }
__device__ __forceinline__ f32x4 sig4(const f32x4& v) { return (f32x4){sigmoidf_(v[0]), sigmoidf_(v[1]), sigmoidf_(v[2]), sigmoidf_(v[3])}; }

struct EpiZ {
    static constexpr bool PERM = true;
    bf16_t* Z; float dq;
    __device__ __forceinline__ void operator()(const f32x4 (&acc)[2][2][4][2], const Unit& u, int wr, int wc, int fr, int fq) const {
        const int row0 = u.pm * BM + wr * 64 + fr, col0 = u.pn * BM + wc * 32 + 8 * sgq(fq); const float kk = -dq * 1.4426950408889634f;
        const bool sg = (u.pn >= 12 && u.pn < 16) || u.pn >= 22; const float sc = (u.pn < 4 ? 0.08838834764831845f : 1.0f) * dq; const int gb = u.pn < 16 ? ZOM : (u.pn < 30 ? ZGM : ZGA);
        if (sg) {
#pragma unroll
            for (int ai = 0; ai < 2; ++ai)
#pragma unroll
                for (int mp = 0; mp < 2; ++mp) { unsigned char* rowp = (unsigned char*)(Z + (size_t)(row0 + ai * HALF + (2 * mp + (fq >> 1)) * 16) * LDZ + gb) + (u.pn * BM + wc * 32 + 16 * (fq & 1) - gb);
#pragma unroll
                    for (int bj = 0; bj < 2; ++bj) { u32x2 o0, o1; o0.x = qu8x4(sig4s(acc[ai][bj][2 * mp][0], kk)); o0.y = qu8x4(sig4s(acc[ai][bj][2 * mp][1], kk)); o1.x = qu8x4(sig4s(acc[ai][bj][2 * mp + 1][0], kk)); o1.y = qu8x4(sig4s(acc[ai][bj][2 * mp + 1][1], kk));
                        *(u32x4*)(rowp + bj * HALF) = widen16(o0, o1); }
                    asm volatile("" ::: "memory"); }
        } else {
#pragma unroll
            for (int ai = 0; ai < 2; ++ai)
#pragma unroll
                for (int m = 0; m < 4; ++m) { bf16_t* rowp = Z + (size_t)(row0 + ai * HALF + m * 16) * LDZ + col0;
#pragma unroll
                    for (int bj = 0; bj < 2; ++bj) *(u32x4*)(rowp + bj * HALF) = pack8(acc[ai][bj][m][0] * sc, acc[ai][bj][m][1] * sc);
                    asm volatile("" ::: "memory"); }
        }
    }
};
template <bool SECOND> struct EpiMerge {
    static constexpr bool PERM = true;
    const bf16_t* Z; unsigned char* MG; unsigned char* M8; float dq;
    __device__ __forceinline__ void operator()(const f32x4 (&acc)[2][2][4][2], const Unit& u, int wr, int wc, int fr, int fq) const {
        const int row0 = u.pm * BM + wr * 64 + fr, col0 = u.pn * BM + wc * 32 + 8 * sgq(fq);
        u32x4 gww[2][2][2], pww[2][2][2];
#pragma unroll
        for (int ai = 0; ai < 2; ++ai)
#pragma unroll
            for (int mp = 0; mp < 2; ++mp) { const size_t r = (size_t)(row0 + ai * HALF + (2 * mp + (fq >> 1)) * 16);
#pragma unroll
                for (int bj = 0; bj < 2; ++bj) { const int c = u.pn * BM + wc * 32 + 16 * (fq & 1) + bj * HALF;
                    gww[ai][mp][bj] = *(const u32x4*)((const unsigned char*)(Z + r * LDZ + (SECOND ? ZGA : ZGM)) + c);
                    if (SECOND) pww[ai][mp][bj] = *(const u32x4*)(MG + r * DM + c); } }
        asm volatile("" ::: "memory");
#pragma unroll
        for (int ai = 0; ai < 2; ++ai)
#pragma unroll
            for (int mp = 0; mp < 2; ++mp) { const size_t r = (size_t)(row0 + ai * HALF + (2 * mp + (fq >> 1)) * 16);
#pragma unroll
                for (int bj = 0; bj < 2; ++bj) { const int c = u.pn * BM + wc * 32 + 16 * (fq & 1) + bj * HALF; u32x2 o[2], gq[2], pq[2];
                    narrow16(gww[ai][mp][bj], gq[0], gq[1]); if (SECOND) narrow16(pww[ai][mp][bj], pq[0], pq[1]);
#pragma unroll
                    for (int q = 0; q < 2; ++q) { const int m = 2 * mp + q;
                        const f32x4 g0 = u8x4_f(gq[q].x), g1 = u8x4_f(gq[q].y);
                        const f32x4 v0 = acc[ai][bj][m][0] * g0, v1 = acc[ai][bj][m][1] * g1;
                        if (SECOND) { const float cq = dq * QM; o[q].x = q8x4(v0 * cq + s8x4_f(pq[q].x), 1.0f); o[q].y = q8x4(v1 * cq + s8x4_f(pq[q].y), 1.0f); }
                        else { o[q].x = q8x4(v0, dq * QM); o[q].y = q8x4(v1, dq * QM); } }
                    *(u32x4*)((SECOND ? M8 : MG) + r * DM + c) = widen16(o[0], o[1]); } }
    }
};
struct EpiResid {
    static constexpr bool PERM = false;
    const float* xin; float* xout;
    __device__ __forceinline__ void operator()(const f32x4 (&acc)[2][2][4][2], const Unit& u, int wr, int wc, int fr, int fq) const {
        const int row0 = u.pm * BM + wr * 64 + fr, col0 = u.pn * BM + wc * 32 + 4 * fq;
#pragma unroll
        for (int ai = 0; ai < 2; ++ai)
#pragma unroll
            for (int m = 0; m < 4; ++m) { const size_t off = (size_t)(row0 + ai * HALF + m * 16) * DM + col0;
#pragma unroll
                for (int bj = 0; bj < 2; ++bj)
#pragma unroll
                    for (int n = 0; n < 2; ++n) { const f32x4 xv = *(const f32x4*)(xin + off + bj * HALF + n * 16); *(f32x4*)(xout + off + bj * HALF + n * 16) = xv + acc[ai][bj][m][n]; }
                asm volatile("" ::: "memory"); }
    }
};
struct EpiResidQ {
    static constexpr bool PERM = true;
    const float* xin32; const bf16_t* xin16; bf16_t* xout; unsigned char* A8; const float* g2; const float* rin; float* part; float dq;
    __device__ __forceinline__ void step(const f32x4 (&acc)[2][2][4][2], const Unit& u, int wc, int fq, int ai, int m, int row, size_t off, float rp, const f32x4 (&gv)[2][2], f32x4 (&y)[2][2], u32x2 (&o8)[2], float& keep) const {
        float ss = 0.f;
#pragma unroll
        for (int bj = 0; bj < 2; ++bj) { const f32x4 y0 = y[bj][0] + acc[ai][bj][m][0] * dq, y1 = y[bj][1] + acc[ai][bj][m][1] * dq;
            *(u32x4*)(xout + off + bj * HALF) = pack8(y0, y1);
            ss += (y0[0] * y0[0] + y0[1] * y0[1]) + (y0[2] * y0[2] + y0[3] * y0[3]) + (y1[0] * y1[0] + y1[1] * y1[1]) + (y1[2] * y1[2] + y1[3] * y1[3]);
            o8[bj].x = q8x4(y0 * gv[bj][0], rp); o8[bj].y = q8x4(y1 * gv[bj][1], rp); }
        ss += xor_shfl<16>(ss);
        { auto rr = __builtin_amdgcn_permlane32_swap(__float_as_uint(ss), __float_as_uint(ss), false, false); ss = __uint_as_float(rr[0]) + __uint_as_float(rr[1]); }
        keep = (fq == m) ? ss : keep;
    }
    __device__ __forceinline__ void operator()(const f32x4 (&acc)[2][2][4][2], const Unit& u, int wr, int wc, int fr, int fq) const {
        const int row0 = u.pm * BM + wr * 64 + fr, col0 = u.pn * BM + wc * 32 + 8 * sgq(fq);
        f32x4 gv[2][2]; float rp[2][4];
#pragma unroll
        for (int bj = 0; bj < 2; ++bj)
#pragma unroll
            for (int n = 0; n < 2; ++n) gv[bj][n] = *(const f32x4*)(g2 + col0 + bj * HALF + 4 * n);
        const int lane_ = 16 * fq + fr; float keep[2] = {0.f, 0.f};
#pragma unroll
        for (int ai = 0; ai < 2; ++ai) { const float rv = rin[u.pm * BM + ai * HALF + wr * 64 + lane_];
#pragma unroll
            for (int m = 0; m < 4; ++m) rp[ai][m] = __int_as_float(__builtin_amdgcn_ds_bpermute(4 * (16 * m + fr), __float_as_int(rv))); }
        if (xin32) {
#pragma unroll
            for (int q = 0; q < 4; ++q) { const int ai = q >> 1; f32x4 xv[2][2][2];
#pragma unroll
                for (int mm = 0; mm < 2; ++mm) { const size_t off = (size_t)(row0 + ai * HALF + (2 * (q & 1) + mm) * 16) * DM + col0;
#pragma unroll
                    for (int bj = 0; bj < 2; ++bj) { xv[mm][bj][0] = *(const f32x4*)(xin32 + off + bj * HALF); xv[mm][bj][1] = *(const f32x4*)(xin32 + off + bj * HALF + 4); } }
                asm volatile("" ::: "memory");
                u32x2 o8[2][2];
#pragma unroll
                for (int mm = 0; mm < 2; ++mm) { const int m = 2 * (q & 1) + mm; const int row = row0 + ai * HALF + m * 16; step(acc, u, wc, fq, ai, m, row, (size_t)row * DM + col0, rp[ai][m] * QA2, gv, xv[mm], o8[mm], keep[ai]); }
#pragma unroll
                for (int bj = 0; bj < 2; ++bj) *(u32x4*)(A8 + (size_t)(row0 + ai * HALF + (2 * (q & 1) + (fq >> 1)) * 16) * DM + u.pn * BM + wc * 32 + 16 * (fq & 1) + bj * HALF) = widen16(o8[0][bj], o8[1][bj]);
                asm volatile("" ::: "memory"); }
        } else {
#pragma unroll
            for (int ai = 0; ai < 2; ++ai) { u32x4 xw[4][2];
#pragma unroll
                for (int m = 0; m < 4; ++m) { const size_t off = (size_t)(row0 + ai * HALF + m * 16) * DM + col0;
#pragma unroll
                    for (int bj = 0; bj < 2; ++bj) xw[m][bj] = *(const u32x4*)(xin16 + off + bj * HALF); }
                asm volatile("" ::: "memory");
#pragma unroll
                for (int mp = 0; mp < 2; ++mp) { u32x2 o8[2][2];
#pragma unroll
                    for (int mm = 0; mm < 2; ++mm) { const int m = 2 * mp + mm; const int row = row0 + ai * HALF + m * 16; f32x4 y[2][2];
#pragma unroll
                        for (int bj = 0; bj < 2; ++bj) unpack8(xw[m][bj], y[bj][0], y[bj][1]);
                        step(acc, u, wc, fq, ai, m, row, (size_t)row * DM + col0, rp[ai][m] * QA2, gv, y, o8[mm], keep[ai]); }
#pragma unroll
                    for (int bj = 0; bj < 2; ++bj) *(u32x4*)(A8 + (size_t)(row0 + ai * HALF + (2 * mp + (fq >> 1)) * 16) * DM + u.pn * BM + wc * 32 + 16 * (fq & 1) + bj * HALF) = widen16(o8[0][bj], o8[1][bj]); }
                asm volatile("" ::: "memory"); }
        }
#pragma unroll
        for (int ai = 0; ai < 2; ++ai) part[(size_t)(u.pn * 4 + wc) * T_TOK + u.pm * BM + ai * HALF + wr * 64 + lane_] = keep[ai];
    }
};
struct EpiSwiGLU {
    static constexpr bool PERM = true;
    unsigned char* HID;
    const float* listf; const volatile LAS int* mcnt; float dq;
    __device__ __forceinline__ void operator()(const f32x4 (&acc)[2][2][4][2], const Unit& u, int wr, int wc, int fr, int fq) const {
        const int row0 = u.pm * BM + wr * 64 + fr, col0 = u.pn * HALF + wc * 32 + 8 * sgq(fq);
        float f_[2][4]; const int cnt_ = mcnt[u.e];
#pragma unroll
        for (int ai = 0; ai < 2; ++ai)
            { const int pos_ = u.aux * BM + ai * HALF + wr * 64 + 16 * fq + fr; const float fv = listf[(size_t)u.e * LISTCAP + (pos_ < cnt_ ? pos_ : 0)];
#pragma unroll
              for (int m = 0; m < 4; ++m) f_[ai][m] = __int_as_float(__builtin_amdgcn_ds_bpermute(4 * (16 * m + fr), __float_as_int(fv))); }
        asm volatile("" ::: "memory");
#pragma unroll
        for (int ai = 0; ai < 2; ++ai)
#pragma unroll
            for (int mp = 0; mp < 2; ++mp) { u32x2 o[2];
#pragma unroll
                for (int q = 0; q < 2; ++q) { const int m = 2 * mp + q; f32x4 h[2];
#pragma unroll
                    for (int n = 0; n < 2; ++n) { const float fd = f_[ai][m] * dq; const f32x4 g = acc[ai][0][m][n] * fd, up = acc[ai][1][m][n] * fd; h[n] = g * sig4(g) * up; }
                    o[q].x = q8x4(h[0], QH); o[q].y = q8x4(h[1], QH); }
                *(u32x4*)(HID + (size_t)(row0 + ai * HALF + (2 * mp + (fq >> 1)) * 16) * DFF + u.pn * HALF + wc * 32 + 16 * (fq & 1)) = widen16(o[0], o[1]); }
    }
};
struct EpiBf16 {
    static constexpr bool PERM = true;
    bf16_t* O; int ldc;
    __device__ __forceinline__ void operator()(const f32x4 (&acc)[2][2][4][2], const Unit& u, int wr, int wc, int fr, int fq) const {
        const int row0 = u.pm * BM + wr * 64 + fr, col0 = u.pn * BM + wc * 32 + 8 * sgq(fq);
        float one_ = 1.0f; asm volatile("" : "+v"(one_));
#pragma unroll
        for (int ai = 0; ai < 2; ++ai)
#pragma unroll
            for (int m = 0; m < 4; ++m) { bf16_t* rowp = O + (size_t)(row0 + ai * HALF + m * 16) * ldc + col0;
#pragma unroll
                for (int bj = 0; bj < 2; ++bj) *(u32x4*)(rowp + bj * HALF) = pack8(acc[ai][bj][m][0] * one_, acc[ai][bj][m][1] * one_); }
    }
};
struct EpiI8 {
    static constexpr bool PERM = true;
    unsigned char* O; int ldc; float q;
    __device__ __forceinline__ void operator()(const f32x4 (&acc)[2][2][4][2], const Unit& u, int wr, int wc, int fr, int fq) const {
        const int row0 = u.pm * BM + wr * 64 + fr, col0 = u.pn * BM + wc * 32 + 8 * sgq(fq);
#pragma unroll
        for (int ai = 0; ai < 2; ++ai)
#pragma unroll
            for (int mp = 0; mp < 2; ++mp) { unsigned char* rowp = O + (size_t)(row0 + ai * HALF + (2 * mp + (fq >> 1)) * 16) * ldc + u.pn * BM + wc * 32 + 16 * (fq & 1);
#pragma unroll
                for (int bj = 0; bj < 2; ++bj) { u32x2 o0, o1; o0.x = q8x4(acc[ai][bj][2 * mp][0], q); o0.y = q8x4(acc[ai][bj][2 * mp][1], q); o1.x = q8x4(acc[ai][bj][2 * mp + 1][0], q); o1.y = q8x4(acc[ai][bj][2 * mp + 1][1], q);
                    *(u32x4*)(rowp + bj * HALF) = widen16(o0, o1); }
                asm volatile("" ::: "memory"); }
    }
};
struct EpiPle {
    static constexpr bool PERM = true;
    const bf16_t* xin; bf16_t* xout; const unsigned char* PP; float dq;
    __device__ __forceinline__ void operator()(const f32x4 (&acc)[2][2][4][2], const Unit& u, int wr, int wc, int fr, int fq) const {
        const int row0 = u.pm * BM + wr * 64 + fr, col0 = u.pn * BM + wc * 32 + 8 * sgq(fq); const float kk = -dq * 1.4426950408889634f;
#pragma unroll
        for (int ai = 0; ai < 2; ++ai) { u32x4 xw[4][2]; u32x4 pww[2][2];
#pragma unroll
            for (int m = 0; m < 4; ++m) { const size_t off = (size_t)(row0 + ai * HALF + m * 16) * DM + col0;
#pragma unroll
                for (int bj = 0; bj < 2; ++bj) xw[m][bj] = *(const u32x4*)(xin + off + bj * HALF); }
#pragma unroll
            for (int mp = 0; mp < 2; ++mp)
#pragma unroll
                for (int bj = 0; bj < 2; ++bj) pww[mp][bj] = *(const u32x4*)(PP + (size_t)(row0 + ai * HALF + (2 * mp + (fq >> 1)) * 16) * DM + u.pn * BM + wc * 32 + 16 * (fq & 1) + bj * HALF);
            asm volatile("" ::: "memory");
            u32x2 pw[4][2];
#pragma unroll
            for (int mp = 0; mp < 2; ++mp)
#pragma unroll
                for (int bj = 0; bj < 2; ++bj) narrow16(pww[mp][bj], pw[2 * mp][bj], pw[2 * mp + 1][bj]);
#pragma unroll
            for (int m = 0; m < 4; ++m) { const size_t off = (size_t)(row0 + ai * HALF + m * 16) * DM + col0;
#pragma unroll
                for (int bj = 0; bj < 2; ++bj) { f32x4 x0, x1; unpack8(xw[m][bj], x0, x1); const f32x4 p0 = s8x4_f(pw[m][bj].x) * (1.0f / QP), p1 = s8x4_f(pw[m][bj].y) * (1.0f / QP);
                    *(u32x4*)(xout + off + bj * HALF) = pack8(x0 + sig4s(acc[ai][bj][m][0], kk) * p0, x1 + sig4s(acc[ai][bj][m][1], kk) * p1); } }
            asm volatile("" ::: "memory"); }
    }
};

__device__ __forceinline__ f32x4 mma16(const bf16x8& a, const bf16x8& b, const f32x4& c) { return __builtin_amdgcn_mfma_f32_16x16x32_bf16(a, b, c, 0, 0, 0); }
__device__ __forceinline__ i32x4 mma16(const i32x4& a, const i32x4& b, const i32x4& c) { return __builtin_amdgcn_mfma_i32_16x16x64_i8(a, b, c, 0, 0, 0); }
template <class Epi, class Sched, bool I8 = false>
__device__ __forceinline__ void gemm_phase(LAS unsigned char* lds, const int K, const Sched& S, const Epi& E, const int wave_id) {
    typedef typename std::conditional<I8, i32x4, f32x4>::type acc_t; typedef typename std::conditional<I8, i32x4, bf16x8>::type frag_t;
    const int tid = (wave_id << 6) | pg8_lane();
    const int wid = __builtin_amdgcn_readfirstlane(tid >> 6), lane = tid & 63, wr = wid >> 2, wc = wid & 3, fr = lane & 15, fq = lane >> 4;
    const int nt = K / BK;
    int RA[2]; unsigned cbA[2], voffB[2];
#pragma unroll
    for (int i = 0; i < 2; ++i) { int R, C; stage_rc(tid * 16 + i * 8192, R, C); const int Rb = Epi::PERM ? ((R & ~31) + perm32(R & 31)) : R;
        RA[i] = R; cbA[i] = (unsigned)C * 2u; voffB[i] = (unsigned)Rb * S.ldbB + (unsigned)C * 2u; }
    const size_t kstep = (size_t)(BK * 2);
    const size_t hstepB = (size_t)HALF * S.ldbB;
    const size_t hstepA = (size_t)HALF * S.ldaB;
    const unsigned ldsw = (unsigned)wid * 1024u;
    const int aoff = lds_byte(wr * 64 + fr, fq * 8), boff = lds_byte(wc * 32 + fr, fq * 8);
#define PG8_SA(b, h) (((b) * 2 + (h)) * HTB)
#define PG8_SB(b, h) ((4 + (b) * 2 + (h)) * HTB)
#define PG8_STAGE(bufoff, gbase, voff) do { _Pragma("unroll") for (int _i = 0; _i < 2; ++_i) \
        __builtin_amdgcn_global_load_lds((const unsigned*)((const char*)(gbase) + (voff)[_i]), (LAS unsigned*)(lds + (bufoff) + ldsw + _i * 8192), 16, 0, 0); } while (0)
#define PG8_LDA(dst, b, h) do { _Pragma("unroll") for (int m = 0; m < 4; ++m) _Pragma("unroll") for (int k = 0; k < 2; ++k) dst[m][k] = *(const LAS frag_t*)(lds + PG8_SA(b, h) + aoff + m * 2048 + k * 1024); } while (0)
#define PG8_LDB(dst, b, h) do { _Pragma("unroll") for (int n = 0; n < 2; ++n) _Pragma("unroll") for (int k = 0; k < 2; ++k) dst[n][k] = *(const LAS frag_t*)(lds + PG8_SB(b, h) + boff + n * 2048 + k * 1024); } while (0)
#define PG8_MMA(ai, bj, At, Bt) do { __builtin_amdgcn_s_setprio(1); _Pragma("unroll") for (int m = 0; m < 4; ++m) _Pragma("unroll") for (int n = 0; n < 2; ++n) _Pragma("unroll") for (int k = 0; k < 2; ++k) \
        acc[ai][bj][m][n] = mma16(Bt[n][k], At[m][k], acc[ai][bj][m][n]); __builtin_amdgcn_s_setprio(0); } while (0)
#define PG8_WAIT_V(n) asm volatile("s_waitcnt vmcnt(" #n ")" ::: "memory")
#define PG8_WAIT_L(n) asm volatile("s_waitcnt lgkmcnt(" #n ")" ::: "memory")
#define PG8_BAR __builtin_amdgcn_s_barrier()
#define PG8_SCHED __builtin_amdgcn_sched_barrier(0)
#define PG8_OFFS(dst, U) do { _Pragma("unroll") for (int _h = 0; _h < 2; ++_h) _Pragma("unroll") for (int _i = 0; _i < 2; ++_i) \
        dst[_h][_i] = (Sched::GATHER ? S.row_index(U, _h * HALF + RA[_i]) : (unsigned)(RA[_i])) * S.ldaB + cbA[_i]; } while (0)
#define PG8_STAGE_A(bufoff, gbase, h, VO) do { if constexpr (Sched::GATHER) { PG8_STAGE(bufoff, gbase, VO[h]); } else { PG8_STAGE(bufoff, (gbase) + (h) * hstepA, VO[0]); } } while (0)
    Unit cur, nxt; int ui = 0;
    if (!S.next(0, cur)) return;
    acc_t acc[2][2][4][2];
#pragma unroll
    for (int a = 0; a < 2; ++a)
#pragma unroll
        for (int b = 0; b < 2; ++b)
#pragma unroll
            for (int m = 0; m < 4; ++m)
#pragma unroll
                for (int n = 0; n < 2; ++n) acc[a][b][m][n] = (acc_t){0, 0, 0, 0};
    frag_t At[4][2], B0[2][2], B1[2][2];
    unsigned vA[2][2], nvA[2][2];
    PG8_OFFS(vA, cur);
    const char* cA = S.a_tile(cur); const char* cB = S.b_tile(cur);
    PG8_STAGE(PG8_SB(0, 0), cB, voffB); PG8_STAGE(PG8_SB(0, 1), cB + hstepB, voffB); PG8_STAGE_A(PG8_SA(0, 0), cA, 0, vA); PG8_STAGE_A(PG8_SA(0, 1), cA, 1, vA);
    if (wr == 1) PG8_BAR;
    PG8_WAIT_V(2); PG8_BAR;
    PG8_STAGE(PG8_SB(1, 0), cB + kstep, voffB); PG8_STAGE_A(PG8_SA(1, 0), cA + kstep, 0, vA); PG8_STAGE(PG8_SB(1, 1), cB + hstepB + kstep, voffB);
    PG8_WAIT_V(6); PG8_BAR;
    for (;;) {
        const bool has_next = S.next(ui + 1, nxt);
        const char* nA = has_next ? S.a_tile(nxt) : cA; const char* nB = has_next ? S.b_tile(nxt) : cB;
        if constexpr (Sched::GATHER) { if (has_next) { PG8_OFFS(nvA, nxt); } else {
#pragma unroll
            for (int h = 0; h < 2; ++h)
#pragma unroll
                for (int i = 0; i < 2; ++i) nvA[h][i] = vA[h][i]; } }
        for (int t = 0; t < nt; t += 2) {
            const bool last = (t == nt - 2);
            const char* a1 = cA + (size_t)(t + 1) * kstep;
            const char* a2 = last ? nA : cA + (size_t)(t + 2) * kstep; const char* b2 = last ? nB : cB + (size_t)(t + 2) * kstep;
            const char* a3 = a2 + kstep; const char* b3 = b2 + kstep;
            unsigned wA[2][2];
#pragma unroll
            for (int h = 0; h < 2; ++h)
#pragma unroll
                for (int i = 0; i < 2; ++i) wA[h][i] = (Sched::GATHER && last) ? nvA[h][i] : vA[h][i];
            PG8_LDB(B0, 0, 0); PG8_LDB(B1, 0, 1); PG8_SCHED; PG8_LDA(At, 0, 0); PG8_STAGE_A(PG8_SA(1, 1), a1, 1, vA);
            PG8_WAIT_V(8); PG8_WAIT_L(0); PG8_BAR; PG8_MMA(0, 0, At, B0); PG8_MMA(0, 1, At, B1); PG8_BAR; PG8_SCHED;
            PG8_LDA(At, 0, 1); PG8_STAGE(PG8_SB(0, 0), b2, voffB); PG8_STAGE(PG8_SB(0, 1), b2 + hstepB, voffB); PG8_STAGE_A(PG8_SA(0, 0), a2, 0, wA);
            PG8_WAIT_V(8); PG8_WAIT_L(0); PG8_BAR; PG8_MMA(1, 0, At, B0); PG8_MMA(1, 1, At, B1); PG8_BAR; PG8_SCHED;
            PG8_LDB(B0, 1, 0); PG8_LDB(B1, 1, 1); PG8_SCHED; PG8_LDA(At, 1, 0); PG8_STAGE_A(PG8_SA(0, 1), a2, 1, wA);
            PG8_WAIT_V(8); PG8_WAIT_L(0); PG8_BAR; PG8_MMA(0, 0, At, B0); PG8_MMA(0, 1, At, B1); PG8_BAR; PG8_SCHED;
            PG8_LDA(At, 1, 1); PG8_STAGE(PG8_SB(1, 0), b3, voffB); PG8_STAGE(PG8_SB(1, 1), b3 + hstepB, voffB); PG8_STAGE_A(PG8_SA(1, 0), a3, 0, wA);
            PG8_WAIT_V(8); PG8_WAIT_L(0); PG8_BAR; PG8_MMA(1, 0, At, B0); PG8_MMA(1, 1, At, B1); PG8_BAR; PG8_SCHED;
        }
        if (wr == 0) PG8_BAR;
        { const int te_ = pg8_lane();
          if constexpr (I8) { f32x4 facc[2][2][4][2];
#pragma unroll
              for (int a = 0; a < 2; ++a)
#pragma unroll
                  for (int b = 0; b < 2; ++b)
#pragma unroll
                      for (int m = 0; m < 4; ++m)
#pragma unroll
                          for (int n = 0; n < 2; ++n) facc[a][b][m][n] = __builtin_convertvector(acc[a][b][m][n], f32x4);
              E(facc, cur, wr, wc, te_ & 15, (te_ >> 4) & 3); }
          else E(acc, cur, wr, wc, te_ & 15, (te_ >> 4) & 3);
        }
        if (!has_next) break;
#pragma unroll
        for (int a = 0; a < 2; ++a)
#pragma unroll
            for (int b = 0; b < 2; ++b)
#pragma unroll
                for (int m = 0; m < 4; ++m)
#pragma unroll
                    for (int n = 0; n < 2; ++n) acc[a][b][m][n] = (acc_t){0, 0, 0, 0};
        cur = nxt; cA = nA; cB = nB; ++ui;
        if constexpr (Sched::GATHER) {
#pragma unroll
        for (int h = 0; h < 2; ++h)
#pragma unroll
            for (int i = 0; i < 2; ++i) vA[h][i] = nvA[h][i]; }
        if (wr == 1) PG8_BAR;
    }
    PG8_WAIT_V(0);
    PG8_BAR;
#undef PG8_SA
#undef PG8_SB
#undef PG8_STAGE
#undef PG8_LDA
#undef PG8_LDB
#undef PG8_MMA
#undef PG8_WAIT_V
#undef PG8_WAIT_L
#undef PG8_BAR
#undef PG8_SCHED
#undef PG8_OFFS
#undef PG8_STAGE_A
}
}

namespace att {
constexpr int D = 128, NW = 8, QBLK = 32, KVBLK = 64;
constexpr float SCALE = 0.088388347648318440f;
constexpr float THR = 8.f;
constexpr int LDQ = LDZ, LDK = LDZ, LDO = LDZ;
constexpr size_t SHM_V = KVBLK * D * 2, SHM_K = KVBLK * D * 2, SHM_ATTN = 2 * SHM_V + 2 * SHM_K + NW * 64 * 4;
#define KSWZ(row, colB) ((row) * 256 + ((colB) ^ (((row) & 7) << 4)))
#define SBAR() __builtin_amdgcn_sched_barrier(0)
__device__ __forceinline__ int crow(int r, int hi) { return (r & 3) + 8 * (r >> 2) + 4 * hi; }
__device__ __forceinline__ unsigned cvtpk(float lo, float hi) { return cvt_pk_bf16(lo, hi); }
__device__ __forceinline__ void partialSM(f32x16& p0, f32x16& p1, float& m_reg, float& mn, float& alpha) {
  constexpr float C = SCALE * 1.4426950408889634f;
  float pmax = p0[0]; for (int r = 1; r < 16; ++r) pmax = fmaxf(pmax, p0[r]); for (int r = 0; r < 16; ++r) pmax = fmaxf(pmax, p1[r]);
  { auto rr = __builtin_amdgcn_permlane32_swap(__float_as_uint(pmax), __float_as_uint(pmax), false, false);
    pmax = fmaxf(__uint_as_float(rr[0]), __uint_as_float(rr[1])); }
  if (__builtin_expect(__all(pmax - m_reg <= THR / SCALE), 1)) { mn = m_reg; alpha = 1.f; }
  else { mn = fmaxf(m_reg, pmax); alpha = __builtin_amdgcn_exp2f((m_reg - mn) * C); m_reg = mn; }
  float mnC = -mn * C;
  for (int r = 0; r < 16; ++r) p0[r] = fmaf(p0[r], C, mnC); for (int r = 0; r < 16; ++r) p1[r] = fmaf(p1[r], C, mnC);
  for (int r = 0; r < 16; ++r) p0[r] = __builtin_amdgcn_exp2f(p0[r]);
}
__device__ __forceinline__ void finishSM(f32x16& p0, f32x16& p1, float alpha, float& l_reg, bf16x8& pa0, bf16x8& pa1, bf16x8& pa2, bf16x8& pa3) {
  for (int r = 0; r < 16; ++r) p1[r] = __builtin_amdgcn_exp2f(p1[r]);
  float ps = 0; for (int r = 0; r < 16; ++r) ps += p0[r]; for (int r = 0; r < 16; ++r) ps += p1[r];
  { auto rr = __builtin_amdgcn_permlane32_swap(__float_as_uint(ps), __float_as_uint(ps), false, false);
    ps = __uint_as_float(rr[0]) + __uint_as_float(rr[1]); }
  l_reg = l_reg * alpha + ps;
#define PK4(P, BASE, OUT) do { unsigned a0 = cvtpk(P[BASE + 0], P[BASE + 1]), a1 = cvtpk(P[BASE + 2], P[BASE + 3]);   \
    unsigned b0 = cvtpk(P[BASE + 4], P[BASE + 5]), b1 = cvtpk(P[BASE + 6], P[BASE + 7]);                              \
    auto r0 = __builtin_amdgcn_permlane32_swap(a0, b0, false, false); auto r1 = __builtin_amdgcn_permlane32_swap(a1, b1, false, false); \
    u32x4 w = {r0[0], r1[0], r0[1], r1[1]}; OUT = *reinterpret_cast<bf16x8*>(&w); } while (0)
  PK4(p0, 0, pa0); PK4(p0, 8, pa1); PK4(p1, 0, pa2); PK4(p1, 8, pa3);
#undef PK4
}
__device__ __forceinline__ void qkt(f32x16& p0, f32x16& p1, const bf16_t* Ks, const bf16x8* qr, int r32, int hi) {
  p0 = f32x16{}; p1 = f32x16{};
  for (int d0 = 0; d0 < 8; ++d0) { int cb = (d0 * 16 + hi * 8) * 2;
    bf16x8 b0 = *reinterpret_cast<const bf16x8*>((const char*)Ks + KSWZ(r32, cb));
    bf16x8 b1 = *reinterpret_cast<const bf16x8*>((const char*)Ks + KSWZ(32 + r32, cb));
    p0 = __builtin_amdgcn_mfma_f32_32x32x16_bf16(b0, qr[d0], p0, 0, 0, 0);
    p1 = __builtin_amdgcn_mfma_f32_32x32x16_bf16(b1, qr[d0], p1, 0, 0, 0); }
}
__device__ __forceinline__ int v_st(int k, int c) { const int kk = (k & ~0xC) | ((k & 4) << 1) | ((k & 8) >> 1); return ((kk >> 3) * 4 + (c >> 5)) * 512 + ((kk & 7) * 32 + (c & 31)) * 2; }
__device__ __forceinline__ int v_rd_base(int lane) { return ((lane & 3) << 3) | (((lane >> 2) & 3) << 6) | (((lane >> 4) & 1) << 5) | (((lane >> 5) & 1) << 8); }
constexpr int v_rd_off(int d0, int ks, int half) { return d0 * 512 + ks * 4096 + half * 2048; }
template <int OFF> __device__ __forceinline__ s16x4 tr_read(int vb) {
  s16x4 r; asm volatile("ds_read_b64_tr_b16 %0, %1 offset:%2" : "=&v"(r) : "v"(vb), "i"(OFF) : "memory"); return r;
}
template <int D0> __device__ __forceinline__ void pv_one(f32x16& od, int vb, bf16x8 pa0, bf16x8 pa1, bf16x8 pa2, bf16x8 pa3) {
  const s16x4 l0 = tr_read<v_rd_off(D0, 0, 0)>(vb), h0 = tr_read<v_rd_off(D0, 0, 1)>(vb), l1 = tr_read<v_rd_off(D0, 1, 0)>(vb), h1 = tr_read<v_rd_off(D0, 1, 1)>(vb);
  const s16x4 l2 = tr_read<v_rd_off(D0, 2, 0)>(vb), h2 = tr_read<v_rd_off(D0, 2, 1)>(vb), l3 = tr_read<v_rd_off(D0, 3, 0)>(vb), h3 = tr_read<v_rd_off(D0, 3, 1)>(vb);
  asm volatile("s_waitcnt lgkmcnt(0)" ::: "memory"); SBAR();
#define PK(L, H) (bf16x8){L[0], L[1], L[2], L[3], H[0], H[1], H[2], H[3]}
  od = __builtin_amdgcn_mfma_f32_32x32x16_bf16(pa0, PK(l0, h0), od, 0, 0, 0);
  od = __builtin_amdgcn_mfma_f32_32x32x16_bf16(pa1, PK(l1, h1), od, 0, 0, 0);
  od = __builtin_amdgcn_mfma_f32_32x32x16_bf16(pa2, PK(l2, h2), od, 0, 0, 0);
  od = __builtin_amdgcn_mfma_f32_32x32x16_bf16(pa3, PK(l3, h3), od, 0, 0, 0);
#undef PK
}
__device__ __forceinline__ void pv_d0(f32x16* o, int vb, bf16x8 pa0, bf16x8 pa1, bf16x8 pa2, bf16x8 pa3) {
  pv_one<0>(o[0], vb, pa0, pa1, pa2, pa3); pv_one<1>(o[1], vb, pa0, pa1, pa2, pa3); pv_one<2>(o[2], vb, pa0, pa1, pa2, pa3); pv_one<3>(o[3], vb, pa0, pa1, pa2, pa3);
}
__device__ __forceinline__ void attn_dense_body(const bf16_t* Qb, const bf16_t* __restrict__ Kh, const bf16_t* __restrict__ Vh, unsigned char* Ob, int seq, char* lds, const int tid, const LAS float* qg, const int qpos0) {
  const int wid = tid >> 6, lane = tid & 63, r32 = lane & 31, hi = lane >> 5;
  bf16_t* V_lds = (bf16_t*)lds; bf16_t* K_lds = (bf16_t*)(lds + 2 * SHM_V);
  float* ws = (float*)(lds + 2 * SHM_V + 2 * SHM_K) + wid * 64; float* li_l = ws; float* al_l = ws + 32;
  float m_reg = -1e30f, l_reg = 0; f32x16 o[4] = {}; bf16x8 qr[8];
  const bf16_t* Qw = Qb + (long)(wid * QBLK + r32) * LDQ + hi * 8;
#pragma unroll
  for (int d0 = 0; d0 < 8; ++d0) qr[d0] = *reinterpret_cast<const bf16x8*>(Qw + d0 * 16);
  { float x[8][8]; float ss = 0.f;
#pragma unroll
    for (int d0 = 0; d0 < 8; ++d0) { const u32x4 w = *reinterpret_cast<const u32x4*>(&qr[d0]);
#pragma unroll
      for (int q = 0; q < 4; ++q) { x[d0][2 * q] = bf_lo(w[q]); x[d0][2 * q + 1] = bf_hi(w[q]); } }
#pragma unroll
    for (int d0 = 0; d0 < 8; ++d0)
#pragma unroll
      for (int j = 0; j < 8; ++j) ss += x[d0][j] * x[d0][j];
    { auto rr = __builtin_amdgcn_permlane32_swap(__float_as_uint(ss), __float_as_uint(ss), false, false); ss = __uint_as_float(rr[0]) + __uint_as_float(rr[1]); }
    const float rstd = 1.0f / sqrtf(ss * (1.f / 128.f) + EPS);
#pragma unroll
    for (int d0 = 0; d0 < 8; ++d0) { const f32x4 g0 = *(const LAS f32x4*)(qg + d0 * 16 + hi * 8), g1 = *(const LAS f32x4*)(qg + d0 * 16 + hi * 8 + 4);
#pragma unroll
      for (int j = 0; j < 4; ++j) { x[d0][j] *= rstd * g0[j]; x[d0][4 + j] *= rstd * g1[j]; } }
    const int pos = qpos0 + wid * QBLK + r32;
#pragma unroll
    for (int hf = 0; hf < 2; ++hf) { const float pv = (float)(hf ? (pos & 63) : (pos >> 6));
#pragma unroll
      for (int e = 0; e < 2; ++e)
#pragma unroll
        for (int j = 0; j < 8; ++j) { const int i = e * 16 + hi * 8 + j; const float a = pv * __builtin_amdgcn_exp2f(-(float)i * (13.287712379549449f / 32.f));
          const float c = __cosf(a), sn = __sinf(a); const float xa = x[hf * 4 + e][j], xb = x[hf * 4 + e + 2][j];
          x[hf * 4 + e][j] = xa * c - xb * sn; x[hf * 4 + e + 2][j] = xb * c + xa * sn; } }
#pragma unroll
    for (int d0 = 0; d0 < 8; ++d0) { u32x4 w;
#pragma unroll
      for (int q = 0; q < 4; ++q) w[q] = cvt_pk_bf16(x[d0][2 * q], x[d0][2 * q + 1]);
      qr[d0] = *reinterpret_cast<const bf16x8*>(&w); } }
  const int sr = tid >> 4, sc = (tid & 15) * 8, vst0 = v_st(sr, sc), vst1 = v_st(32 + sr, sc);
  const int vb0 = (int)(uintptr_t)V_lds + v_rd_base(lane);
  struct { bf16x8 vs0, vs1, ks0, ks1; } sr_[2];
  const unsigned lo0 = (unsigned)(sr * LDK + sc) * 2u;
  constexpr int VDELTA = (ZVA - ZKA) * 2;
#define SLOAD(i, k0) do { const char* kb0_ = (const char*)Kh + (size_t)(k0) * (size_t)(LDK * 2); const char* kb1_ = kb0_ + (size_t)32 * LDK * 2; \
    sr_[i].vs0 = *reinterpret_cast<const bf16x8*>(kb0_ + VDELTA + lo0); sr_[i].vs1 = *reinterpret_cast<const bf16x8*>(kb1_ + VDELTA + lo0); \
    sr_[i].ks0 = *reinterpret_cast<const bf16x8*>(kb0_ + lo0); sr_[i].ks1 = *reinterpret_cast<const bf16x8*>(kb1_ + lo0); } while (0)
#define SWRITE(b, i) do { *(bf16x8*)((char*)V_lds + (b) * SHM_V + vst0) = sr_[i].vs0;          \
    *(bf16x8*)((char*)V_lds + (b) * SHM_V + vst1) = sr_[i].vs1; int kc = sc * 2;               \
    *(bf16x8*)((char*)K_lds + (b) * SHM_K + KSWZ(sr, kc)) = sr_[i].ks0;                       \
    *(bf16x8*)((char*)K_lds + (b) * SHM_K + KSWZ(32 + sr, kc)) = sr_[i].ks1; } while (0)
#define SWAIT() do { asm volatile("s_waitcnt vmcnt(4)" ::: "memory"); } while (0)
#define RESC(a) do { if (__any((a) < 1.f)) { if (hi == 0) al_l[r32] = (a); asm volatile("s_waitcnt lgkmcnt(0)" ::: "memory"); \
    for (int d = 0; d < 4; ++d) for (int r = 0; r < 16; ++r) o[d][r] *= al_l[crow(r, hi)]; } } while (0)
  f32x16 pA0, pA1, pB0, pB1; float mnA, mnB, alA, alB; bf16x8 pa0, pa1, pa2, pa3; const int NT = seq / KVBLK;
  constexpr int SE = 0, SO = 1;
  SLOAD(SE, 0); asm volatile("s_waitcnt vmcnt(0)" ::: "memory"); SWRITE(0, SE); __syncthreads();
  qkt(pA0, pA1, K_lds, qr, r32, hi); partialSM(pA0, pA1, m_reg, mnA, alA);
  SLOAD(SO, KVBLK); if (2 < NT) SLOAD(SE, 2 * KVBLK);
  SWAIT(); SWRITE(1, SO); __syncthreads();
  for (int j = 1; j + 1 < NT; j += 2) {
    SBAR(); qkt(pB0, pB1, (bf16_t*)((char*)K_lds + SHM_K), qr, r32, hi);
    finishSM(pA0, pA1, alA, l_reg, pa0, pa1, pa2, pa3); SBAR();
    SLOAD(SO, (j + 2) * KVBLK); SBAR();
    pv_d0(o, vb0, pa0, pa1, pa2, pa3); partialSM(pB0, pB1, m_reg, mnB, alB);
    __syncthreads(); SWAIT(); SWRITE(0, SE);
    RESC(alB); __syncthreads();
    SBAR(); qkt(pA0, pA1, K_lds, qr, r32, hi);
    finishSM(pB0, pB1, alB, l_reg, pa0, pa1, pa2, pa3); SBAR();
    if (j + 3 < NT) SLOAD(SE, (j + 3) * KVBLK); SBAR();
    pv_d0(o, vb0 + (int)SHM_V, pa0, pa1, pa2, pa3); partialSM(pA0, pA1, m_reg, mnA, alA);
    __syncthreads(); SWAIT(); SWRITE(1, SO);
    RESC(alA); __syncthreads();
  }
  SBAR(); qkt(pB0, pB1, (bf16_t*)((char*)K_lds + SHM_K), qr, r32, hi);
  finishSM(pA0, pA1, alA, l_reg, pa0, pa1, pa2, pa3); SBAR();
  pv_d0(o, vb0, pa0, pa1, pa2, pa3); partialSM(pB0, pB1, m_reg, mnB, alB);
  __syncthreads(); RESC(alB);
  finishSM(pB0, pB1, alB, l_reg, pa0, pa1, pa2, pa3); SBAR();
  pv_d0(o, vb0 + (int)SHM_V, pa0, pa1, pa2, pa3);
  if (hi == 0) li_l[r32] = l_reg; asm volatile("s_waitcnt lgkmcnt(0)" ::: "memory");
  float rli[16];
#pragma unroll
  for (int r = 0; r < 16; ++r) rli[r] = __builtin_amdgcn_rcpf(li_l[crow(r, hi)]);
  unsigned char* Ow = Ob + (long)(wid * QBLK) * 1024;
  { const int jq = r32 & 3; const unsigned selq = 0x0c0c0000u | (unsigned)((4 + jq) << 8) | (unsigned)jq;
#pragma unroll
    for (int g = 0; g < 4; ++g) { unsigned char* rowp = Ow + (long)(8 * g + 4 * hi + jq) * 1024 + (r32 & ~3);
#pragma unroll
      for (int d0 = 0; d0 < 4; ++d0) {
        const unsigned w = q8x4((f32x4){o[d0][4 * g] * rli[4 * g], o[d0][4 * g + 1] * rli[4 * g + 1], o[d0][4 * g + 2] * rli[4 * g + 2], o[d0][4 * g + 3] * rli[4 * g + 3]}, QYA);
        const unsigned t0 = (unsigned)__builtin_amdgcn_mov_dpp((int)w, 0x00, 0xf, 0xf, false), t1 = (unsigned)__builtin_amdgcn_mov_dpp((int)w, 0x55, 0xf, 0xf, false);
        const unsigned t2 = (unsigned)__builtin_amdgcn_mov_dpp((int)w, 0xaa, 0xf, 0xf, false), t3 = (unsigned)__builtin_amdgcn_mov_dpp((int)w, 0xff, 0xf, 0xf, false);
        const unsigned lo = __builtin_amdgcn_perm(t1, t0, selq), hi2 = __builtin_amdgcn_perm(t3, t2, selq);
        *(unsigned*)(rowp + d0 * 32) = lo | (hi2 << 16); } } }
  __syncthreads();
#undef SLOAD
#undef SWRITE
#undef SWAIT
#undef RESC
}
#undef KSWZ
}

__device__ __forceinline__ int hw_lane() { int l; asm volatile("v_mbcnt_lo_u32_b32 %0, -1, 0\n\tv_mbcnt_hi_u32_b32 %0, -1, %0" : "=v"(l)); return l; }
__device__ __forceinline__ int hw_tid(int wave) { return (wave << 6) | hw_lane(); }
__device__ __forceinline__ int opq_idx(int i) { asm volatile("" : "+s"(i)); return i; }
__device__ __forceinline__ size_t opq_off(size_t o) { asm volatile("" : "+s"(o)); return o; }
struct Frame {
    LAS unsigned char* lds; unsigned char* ldsg;
    volatile LAS unsigned* MISC;
    unsigned* ctl;
    int tid, lane, wave, vcu, G;
};

__device__ __forceinline__ void tr_item(const float* __restrict__ W, int ldw, int k0, int n0, bf16_t* __restrict__ WT, int ldt, int drow0, LAS float* scr, int lane) {
#pragma unroll 8
    for (int i = 0; i < 32; ++i) { const int kk = 2 * i + (lane >> 5); scr[kk * 33 + (lane & 31)] = W[(size_t)(k0 + kk) * ldw + n0 + (lane & 31)]; }
    LDS_WAIT();
    const int c = lane & 7;
#pragma unroll
    for (int j = 0; j < 4; ++j) { const int n = (lane >> 3) + 8 * j; const LAS float* s = scr + (8 * c) * 33 + n;
        u32x4 o; o.x = cvt_pk_bf16(s[0 * 33], s[1 * 33]); o.y = cvt_pk_bf16(s[2 * 33], s[3 * 33]); o.z = cvt_pk_bf16(s[4 * 33], s[5 * 33]); o.w = cvt_pk_bf16(s[6 * 33], s[7 * 33]);
        *(u32x4*)(WT + (size_t)(drow0 + n) * ldt + k0 + 8 * c) = o; }
    LDS_WAIT();
}
__device__ __forceinline__ void tr_item8(const float* __restrict__ W, int ldw, int k0, int n0, unsigned char* __restrict__ WT, int ldt, int drow0, float qs, LAS float* scr, int lane) {
    f32x4 t[8];
#pragma unroll
    for (int i = 0; i < 8; ++i) t[i] = *(const f32x4*)(W + (size_t)(k0 + (lane >> 3) + 8 * i) * ldw + n0 + 4 * (lane & 7));
#pragma unroll
    for (int i = 0; i < 8; ++i) *(LAS f32x4*)(scr + ((lane >> 3) + 8 * i) * 36 + 4 * (lane & 7)) = t[i];
    LDS_WAIT();
    const int n = lane >> 1, kh = lane & 1; const LAS float* s = scr + (32 * kh) * 36 + n;
    u32x4 o0, o1;
#pragma unroll
    for (int q = 0; q < 4; ++q) { o0[q] = q8(s[(4 * q) * 36], qs) | (q8(s[(4 * q + 1) * 36], qs) << 8) | (q8(s[(4 * q + 2) * 36], qs) << 16) | (q8(s[(4 * q + 3) * 36], qs) << 24);
        o1[q] = q8(s[(16 + 4 * q) * 36], qs) | (q8(s[(17 + 4 * q) * 36], qs) << 8) | (q8(s[(18 + 4 * q) * 36], qs) << 16) | (q8(s[(19 + 4 * q) * 36], qs) << 24); }
    unsigned char* dst = WT + (size_t)(drow0 + n) * ldt + k0 + 32 * kh;
    *(u32x4*)dst = o0; *(u32x4*)(dst + 16) = o1;
    LDS_WAIT();
}
__device__ __forceinline__ void tr_item8x2(const float* __restrict__ W, int ldw, int k0, int n0, unsigned char* __restrict__ WT, int ldt, int drow0, float qs, LAS float* scr, int lane) {
    f32x4 t[16];
#pragma unroll
    for (int i = 0; i < 16; ++i) t[i] = *(const f32x4*)(W + (size_t)(k0 + (lane >> 3) + 8 * i) * ldw + n0 + 4 * (lane & 7));
    const int n = lane >> 1, kh = lane & 1; const LAS float* s = scr + (32 * kh) * 36 + n;
    u32x4 o[4];
#pragma unroll
    for (int h = 0; h < 2; ++h) {
#pragma unroll
        for (int i = 0; i < 8; ++i) *(LAS f32x4*)(scr + ((lane >> 3) + 8 * i) * 36 + 4 * (lane & 7)) = t[8 * h + i];
        LDS_WAIT();
#pragma unroll
        for (int q = 0; q < 4; ++q) { o[2 * h][q] = q8x4((f32x4){s[(4 * q) * 36], s[(4 * q + 1) * 36], s[(4 * q + 2) * 36], s[(4 * q + 3) * 36]}, qs);
            o[2 * h + 1][q] = q8x4((f32x4){s[(16 + 4 * q) * 36], s[(17 + 4 * q) * 36], s[(18 + 4 * q) * 36], s[(19 + 4 * q) * 36]}, qs); }
        LDS_WAIT(); }
    unsigned char* dst = WT + (size_t)(drow0 + n) * ldt + k0 + 32 * kh;
    *(u32x4*)dst = o[0]; *(u32x4*)(dst + 16) = o[1]; *(u32x4*)(dst + 64) = o[2]; *(u32x4*)(dst + 80) = o[3];
}
struct LayerW { const float *w_in, *w_bm, *w_ba, *w_out, *w_rg, *w_re, *w_eg, *w_eu, *w_ed, *w_pg, *w_pp, *p; };
template <int PART>
__device__ __forceinline__ void convert_weights(Frame& F, const LayerW& L, unsigned char* ws) {
    LAS float* scr = (LAS float*)(F.lds + F.wave * 16384);
    const int gw = F.vcu * NWAVES + F.wave, NGW = F.G * NWAVES, lane = F.lane;
    bf16_t* WIN = (bf16_t*)(ws + opq_off(WS_WIN)); bf16_t* WG = (bf16_t*)(ws + opq_off(WS_WG)); bf16_t* WR = (bf16_t*)(ws + opq_off(WS_WR));
    bf16_t* WBM = (bf16_t*)(ws + opq_off(WS_WBM)); bf16_t* WBA = (bf16_t*)(ws + opq_off(WS_WBA)); bf16_t* WOUT = (bf16_t*)(ws + opq_off(WS_WOUT));
    bf16_t* WPG = (bf16_t*)(ws + opq_off(WS_WPG)); bf16_t* WPP = (bf16_t*)(ws + opq_off(WS_WPP)); bf16_t* WGU = (bf16_t*)(ws + opq_off(WS_WGU)); bf16_t* WD = (bf16_t*)(ws + opq_off(WS_WD));
    constexpr int I_G = 8192, I_U = 8192, I_D = 8192, I_IN = 16 * 305, I_BM = 512, I_BA = 512, I_OUT = 1024, I_PG = 1024, I_PP = 256;
    constexpr int NITEMS = I_G + I_U + I_D + I_IN + I_BM + I_BA + I_OUT + I_PG + I_PP;
    for (int it = gw + (PART == 0 ? I_G + I_U + I_D : 0); it < (PART == 0 ? I_G + I_U + I_D + I_IN : NITEMS - I_IN); it += NGW) {
        int r = (PART == 1 && it >= I_G + I_U + I_D) ? it + I_IN : it;
        if (r < I_G + I_U) { const int which = r >= I_G; if (which) r -= I_G; const int e = r >> 8, q = r & 255, kb = q >> 4, nb = q & 15, n0 = nb * 32;
            tr_item8x2((which ? L.w_eu : L.w_eg) + (size_t)e * DM * DFF, DFF, kb * 128, n0, (unsigned char*)WGU, DM, e * 1024 + (n0 >> 7) * 256 + which * 128 + (n0 & 127), QW_2048, scr, lane); continue; } r -= I_G + I_U;
        if (r < I_D) { const int e = r >> 8, q = r & 255, kb = q >> 6, nb = q & 63;
            tr_item8x2(L.w_ed + (size_t)e * DFF * DM, DM, kb * 128, nb * 32, (unsigned char*)WD, DFF, e * 2048 + nb * 32, QW_512, scr, lane); continue; } r -= I_D;
        if (r < I_IN) { const int kb = r / 305, nb = r % 305, n0 = nb * 32;
            if (n0 >= 4096 && n0 < 4128) tr_item8x2(L.w_in, INW, kb * 128, n0, (unsigned char*)WG, DM, 0, QW_2048, scr, lane);
            else tr_item8x2(L.w_in, INW, kb * 128, n0, (unsigned char*)WIN, DM, n0 < 4096 ? n0 : n0 - 32, QW_2048, scr, lane);
            continue; } r -= I_IN;
        if (r < I_BM) { tr_item8x2(L.w_bm, DM, (r >> 6) * 128, (r & 63) * 32, (unsigned char*)WBM, 1024, (r & 63) * 32, QW_1024, scr, lane); continue; } r -= I_BM;
        if (r < I_BA) { tr_item8x2(L.w_ba, DM, (r >> 6) * 128, (r & 63) * 32, (unsigned char*)WBA, 1024, (r & 63) * 32, QW_1024, scr, lane); continue; } r -= I_BA;
        if (r < I_OUT) { tr_item8x2(L.w_out, DM, (r >> 6) * 128, (r & 63) * 32, (unsigned char*)WOUT, DM, (r & 63) * 32, QW_2048, scr, lane); continue; } r -= I_OUT;
        if (r < I_PG) { tr_item8x2(L.w_pg, DM, (r >> 6) * 128, (r & 63) * 32, (unsigned char*)WPG, DM, (r & 63) * 32, QW_2048, scr, lane); continue; } r -= I_PG;
        tr_item(L.w_pp, DM, (r >> 6) * 64, (r & 63) * 32, WPP, PLE, (r & 63) * 32, scr, lane);
    }
    if (PART == 0) return;
    const int gt = F.vcu * (NWAVES * 64) + F.tid, NGT = F.G * NWAVES * 64;
    for (int idx = gt; idx < 48 * DM; idx += NGT) { const int n = idx >> 11, k = idx & 2047;
        const float v = n < 4 ? L.w_rg[k * 4 + n] : (n < 36 ? L.w_re[k * 32 + (n - 4)] : 0.f);
        ((unsigned char*)WR)[idx] = (unsigned char)q8(v, QW_2048); }
    bf16_t* PB = (bf16_t*)(ws + opq_off(WS_PB));
    for (int idx = gt; idx < T_TOK * PLE / 8; idx += NGT) { const f32x4 a = *(const f32x4*)(L.p + (size_t)idx * 8), b = *(const f32x4*)(L.p + (size_t)idx * 8 + 4);
        *(u32x4*)(PB + (size_t)idx * 8) = pg8::pack8(a, b); }
}

__device__ __forceinline__ void norm_row_bf16(const float* xrow, const float* g, bf16_t* orow, int lane, unsigned char* o8row = nullptr) {
    const f32x4* xr = (const f32x4*)xrow + lane; const f32x4* gr = (const f32x4*)g + lane;
    f32x4 v[8]; float s = 0.f;
#pragma unroll
    for (int j = 0; j < 8; ++j) { v[j] = xr[64 * j]; s += (v[j].x * v[j].x + v[j].y * v[j].y) + (v[j].z * v[j].z + v[j].w * v[j].w); }
    const float rstd = 1.0f / sqrtf(wave_sum(s) * (1.f / DM) + EPS);
    u32x2* o8 = (u32x2*)orow + lane;
#pragma unroll
    for (int j = 0; j < 8; ++j) { const f32x4 gv = gr[64 * j]; const f32x4 y = v[j] * rstd * gv;
        if (orow) { u32x2 w; w.x = cvt_pk_bf16(y.x, y.y); w.y = cvt_pk_bf16(y.z, y.w); o8[64 * j] = w; }
        if (o8row) ((unsigned*)o8row)[lane + 64 * j] = q8x4(y, QA); }
}

template <bool FINAL>
__device__ __forceinline__ void norm_pass(const float* x, float* outf, unsigned char* out8, const float* g, int gw, int NGW, int lane, float* rs_out = nullptr) {
    f32x4 gv[8], a[8], b[8];
#pragma unroll
    for (int j = 0; j < 8; ++j) gv[j] = ((const f32x4*)g)[lane + 64 * j];
#define NP_LOAD(v, m) do { const f32x4* xr_ = (const f32x4*)(x + (size_t)(m) * DM) + lane; _Pragma("unroll") for (int j = 0; j < 8; ++j) v[j] = xr_[64 * j]; } while (0)
#define NP_DO(v, m) do { float s_ = 0.f; _Pragma("unroll") for (int j = 0; j < 8; ++j) s_ += (v[j].x * v[j].x + v[j].y * v[j].y) + (v[j].z * v[j].z + v[j].w * v[j].w); \
        const float rstd_ = 1.0f / sqrtf(wave_sum(s_) * (1.f / DM) + EPS); if (rs_out && lane == 0) rs_out[m] = rstd_; \
        if (FINAL) { f32x4* o_ = (f32x4*)(outf + (size_t)(m) * DM) + lane; _Pragma("unroll") for (int j = 0; j < 8; ++j) o_[64 * j] = v[j] * rstd_ * gv[j]; } \
        else { unsigned* o_ = (unsigned*)(out8 + (size_t)(m) * DM) + lane; _Pragma("unroll") for (int j = 0; j < 8; ++j) o_[64 * j] = q8x4(v[j] * rstd_ * gv[j], QA); } } while (0)
    int m = gw;
    if (m < T_TOK) NP_LOAD(a, m);
    while (m < T_TOK) {
        const int m2 = m + NGW; if (m2 < T_TOK) NP_LOAD(b, m2);
        NP_DO(a, m);
        if (m2 >= T_TOK) break;
        const int m3 = m2 + NGW; if (m3 < T_TOK) NP_LOAD(a, m3);
        NP_DO(b, m2);
        m = m3;
    }
#undef NP_LOAD
#undef NP_DO
}

template <bool FINAL>
__device__ __forceinline__ void norm_pass_b16(const bf16_t* x, float* outf, unsigned char* out8, const float* g, int gw, int NGW, int lane, float* rs_out = nullptr) {
    f32x4 gv[8]; u32x4 a[4], b[4];
#pragma unroll
    for (int j = 0; j < 4; ++j) { gv[2 * j] = ((const f32x4*)g)[2 * (lane + 64 * j)]; gv[2 * j + 1] = ((const f32x4*)g)[2 * (lane + 64 * j) + 1]; }
#define NPB_LOAD(v, m) do { const u32x4* xr_ = (const u32x4*)(x + (size_t)(m) * DM) + lane; _Pragma("unroll") for (int j = 0; j < 4; ++j) v[j] = xr_[64 * j]; } while (0)
#define NPB_DO(v, m) do { f32x4 t_[8]; float s_ = 0.f; _Pragma("unroll") for (int j = 0; j < 4; ++j) pg8::unpack8(v[j], t_[2 * j], t_[2 * j + 1]); \
        _Pragma("unroll") for (int j = 0; j < 8; ++j) s_ += (t_[j].x * t_[j].x + t_[j].y * t_[j].y) + (t_[j].z * t_[j].z + t_[j].w * t_[j].w); \
        const float rstd_ = 1.0f / sqrtf(wave_sum(s_) * (1.f / DM) + EPS); if (rs_out && lane == 0) rs_out[m] = rstd_; \
        if (FINAL) { f32x4* o_ = (f32x4*)(outf + (size_t)(m) * DM) + 2 * lane; _Pragma("unroll") for (int j = 0; j < 4; ++j) { o_[128 * j] = t_[2 * j] * rstd_ * gv[2 * j]; o_[128 * j + 1] = t_[2 * j + 1] * rstd_ * gv[2 * j + 1]; } } \
        else { u32x2* o_ = (u32x2*)(out8 + (size_t)(m) * DM) + lane; _Pragma("unroll") for (int j = 0; j < 4; ++j) { u32x2 q_; q_.x = q8x4(t_[2 * j] * rstd_ * gv[2 * j], QA); q_.y = q8x4(t_[2 * j + 1] * rstd_ * gv[2 * j + 1], QA); o_[64 * j] = q_; } } } while (0)
    int m = gw;
    if (m < T_TOK) NPB_LOAD(a, m);
    while (m < T_TOK) {
        const int m2 = m + NGW; if (m2 < T_TOK) NPB_LOAD(b, m2);
        NPB_DO(a, m);
        if (m2 >= T_TOK) break;
        const int m3 = m2 + NGW; if (m3 < T_TOK) NPB_LOAD(a, m3);
        NPB_DO(b, m2);
        m = m3;
    }
#undef NPB_LOAD
#undef NPB_DO
}

__device__ __forceinline__ void norm_pass_b16w(const bf16_t* x, unsigned char* out8, const float* g, int gw, int NGW, int lane, float* rs_out) {
    f32x4 gv[8]; u32x4 a[4], b[4];
#pragma unroll
    for (int jj = 0; jj < 2; ++jj)
#pragma unroll
        for (int q = 0; q < 4; ++q) gv[4 * jj + q] = ((const f32x4*)g)[4 * (lane + 64 * jj) + q];
#define NPW_LOAD(v, m) do { const u32x4* xr_ = (const u32x4*)(x + (size_t)(m) * DM) + 2 * lane; _Pragma("unroll") for (int jj = 0; jj < 2; ++jj) { v[2 * jj] = xr_[128 * jj]; v[2 * jj + 1] = xr_[128 * jj + 1]; } } while (0)
#define NPW_DO(v, m) do { f32x4 t_[8]; float s_ = 0.f; _Pragma("unroll") for (int j = 0; j < 4; ++j) pg8::unpack8(v[j], t_[2 * j], t_[2 * j + 1]); \
        _Pragma("unroll") for (int j = 0; j < 8; ++j) s_ += (t_[j].x * t_[j].x + t_[j].y * t_[j].y) + (t_[j].z * t_[j].z + t_[j].w * t_[j].w); \
        const float rstd_ = 1.0f / sqrtf(wave_sum(s_) * (1.f / DM) + EPS); if (rs_out && lane == 0) rs_out[m] = rstd_; \
        u32x4* o_ = (u32x4*)(out8 + (size_t)(m) * DM) + lane; \
        _Pragma("unroll") for (int jj = 0; jj < 2; ++jj) { u32x4 q_; _Pragma("unroll") for (int q = 0; q < 4; ++q) q_[q] = q8x4(t_[4 * jj + q] * rstd_ * gv[4 * jj + q], QA); o_[64 * jj] = q_; } } while (0)
    int m = gw;
    if (m < T_TOK) NPW_LOAD(a, m);
    while (m < T_TOK) {
        const int m2 = m + NGW; if (m2 < T_TOK) NPW_LOAD(b, m2);
        NPW_DO(a, m);
        if (m2 >= T_TOK) break;
        const int m3 = m2 + NGW; if (m3 < T_TOK) NPW_LOAD(a, m3);
        NPW_DO(b, m2);
        m = m3;
    }
#undef NPW_LOAD
#undef NPW_DO
}

template <int NT>
__device__ __forceinline__ void skinny16(const bf16_t* __restrict__ A, size_t lda, const bf16_t* __restrict__ Bt, int K, int r0, int fr, int fq, f32x4 (&acc)[NT]) {
    const bf16_t* ap = A + (size_t)(r0 + fr) * lda + 8 * fq; const bf16_t* bp = Bt + (size_t)fr * K + 8 * fq;
#pragma unroll
    for (int n = 0; n < NT; ++n) acc[n] = (f32x4){0.f, 0.f, 0.f, 0.f};
#pragma unroll 4
    for (int ks = 0; ks < K / 32; ++ks) { const bf16x8 a = *(const bf16x8*)(ap + 32 * ks);
#pragma unroll
        for (int n = 0; n < NT; ++n) { const bf16x8 b = *(const bf16x8*)(bp + (size_t)(16 * n) * K + 32 * ks); acc[n] = __builtin_amdgcn_mfma_f32_16x16x32_bf16(a, b, acc[n], 0, 0, 0); } }
}

template <int NT>
__device__ __forceinline__ void skinny16_i8(const unsigned char* __restrict__ A, size_t lda, const unsigned char* __restrict__ Bt, int K, int r0, int fr, int fq, float deq, f32x4 (&acc)[NT]) {
    const unsigned char* ap = A + (size_t)(r0 + fr) * lda + 16 * fq; const unsigned char* bp = Bt + (size_t)fr * K + 16 * fq;
    i32x4 ia[NT];
#pragma unroll
    for (int n = 0; n < NT; ++n) ia[n] = (i32x4){0, 0, 0, 0};
#pragma unroll 4
    for (int ks = 0; ks < K / 64; ++ks) { const i32x4 a = *(const i32x4*)(ap + 64 * ks);
#pragma unroll
        for (int n = 0; n < NT; ++n) { const i32x4 b = *(const i32x4*)(bp + (size_t)(16 * n) * K + 64 * ks); ia[n] = __builtin_amdgcn_mfma_i32_16x16x64_i8(a, b, ia[n], 0, 0, 0); } }
#pragma unroll
    for (int n = 0; n < NT; ++n) acc[n] = __builtin_convertvector(ia[n], f32x4) * deq;
}

__device__ __forceinline__ void qk_prepass(Frame& F, bf16_t* Z, const float* kg) {
    const int gw = F.vcu * NWAVES + F.wave, NGW = F.G * NWAVES, lane = F.lane;
    const int half = lane >> 5, isb = (lane >> 4) & 1, i0 = 2 * (lane & 15);
    const float f0 = __builtin_amdgcn_exp2f(-(float)i0 * (13.287712379549449f / 32.f)), f1 = __builtin_amdgcn_exp2f(-(float)(i0 + 1) * (13.287712379549449f / 32.f));
    const f32x2 gk = *(const f32x2*)(kg + 2 * lane);
    for (int tok = gw; tok < T_TOK; tok += NGW) {
        const int pos = tok & (SEQ - 1);
        unsigned* p = (unsigned*)(Z + (size_t)tok * LDZ + ZQA) + lane;
        unsigned w[2];
#pragma unroll
        for (int s = 0; s < 2; ++s) w[s] = p[64 * (8 + s)];
        const float pv = (float)(half ? (pos & 63) : (pos >> 6));
        const float a0 = pv * f0, a1 = pv * f1;
        const float c0 = __cosf(a0), s0 = __sinf(a0), c1 = __cosf(a1), s1 = __sinf(a1);
        const float sg0 = isb ? s0 : -s0, sg1 = isb ? s1 : -s1;
#pragma unroll
        for (int s = 0; s < 2; ++s) {
            float x0 = bf_lo(w[s]), x1 = bf_hi(w[s]);
            const float ss = wave_sum(x0 * x0 + x1 * x1);
            const float rstd = 1.0f / sqrtf(ss * (1.f / 128.f) + EPS);
            x0 = x0 * rstd * gk.x; x1 = x1 * rstd * gk.y;
            const float q0 = xor_shfl<16>(x0), q1 = xor_shfl<16>(x1);
            p[64 * (8 + s)] = cvt_pk_bf16(x0 * c0 + q0 * sg0, x1 * c1 + q1 * sg1);
        }
    }
}

__device__ __forceinline__ void ym_combine(Frame& F, bf16_t* Z, const bf16_t* HFW, const bf16_t* HBW, const float* g) {
    const int gw = F.vcu * NWAVES + F.wave, NGW = F.G * NWAVES, lane = F.lane;
    f32x4 gv[4];
#pragma unroll
    for (int q = 0; q < 4; ++q) gv[q] = *(const f32x4*)(g + 16 * lane + 4 * q) * (1.0f / 255.0f);
    u32x4 fa[2], ba[2], fb[2], bb[2]; u32x4 sa, sb;
#define YM_TOK(i) ((gw + (i) * NGW) < T_TOK ? (gw + (i) * NGW) : (T_TOK - 1))
#define YM_LOAD(f, b, s, tok) do { const size_t o_ = (size_t)(tok) * 1024 + 16 * lane; const unsigned char* zp_ = (const unsigned char*)(Z + (size_t)(tok) * LDZ + ZOM) + 16 * lane; \
        s = *(const u32x4*)zp_; _Pragma("unroll") for (int q = 0; q < 2; ++q) { f[q] = *(const u32x4*)(HFW + o_ + 8 * q); b[q] = *(const u32x4*)(HBW + o_ + 8 * q); } } while (0)
#define YM_DO(f, b, s, tok) do { float v[16]; \
        _Pragma("unroll") for (int q = 0; q < 2; ++q) { f32x4 a0, a1, b0, b1; pg8::unpack8(f[q], a0, a1); pg8::unpack8(b[q], b0, b1); \
            _Pragma("unroll") for (int i = 0; i < 4; ++i) { v[8 * q + i] = a0[i] + b0[i]; v[8 * q + 4 + i] = a1[i] + b1[i]; } } \
        float ss = 0.f; _Pragma("unroll") for (int i = 0; i < 16; ++i) ss += v[i] * v[i]; \
        ss += xor_shfl<1>(ss); ss += xor_shfl<2>(ss); ss += xor_shfl<4>(ss); \
        const float rstd = 1.0f / sqrtf(ss * (1.f / 128.f) + EPS); \
        u32x4 o; \
        _Pragma("unroll") for (int q = 0; q < 2; ++q) { const f32x4 s0 = u8x4_f(s[2 * q]), s1 = u8x4_f(s[2 * q + 1]); f32x4 y0, y1; \
            _Pragma("unroll") for (int i = 0; i < 4; ++i) { y0[i] = v[8 * q + i] * rstd * gv[2 * q][i] * s0[i]; y1[i] = v[8 * q + 4 + i] * rstd * gv[2 * q + 1][i] * s1[i]; } \
            o[2 * q] = q8x4(y0, QA); o[2 * q + 1] = q8x4(y1, QA); } \
        *(u32x4*)((unsigned char*)(Z + (size_t)(tok) * LDZ + ZQM) + 16 * lane) = o; } while (0)
    const int ntok = (T_TOK - gw + NGW - 1) / NGW;
    YM_LOAD(fa, ba, sa, YM_TOK(0));
    for (int i = 0; i < ntok; i += 2) {
        YM_LOAD(fb, bb, sb, YM_TOK(i + 1));
        YM_DO(fa, ba, sa, YM_TOK(i));
        YM_LOAD(fa, ba, sa, YM_TOK(i + 2));
        if (i + 1 < ntok) YM_DO(fb, bb, sb, YM_TOK(i + 1));
    }
#undef YM_TOK
#undef YM_LOAD
#undef YM_DO
}

__device__ __forceinline__ unsigned offb(unsigned row, unsigned ch) { return 256u * row + 16u * (ch ^ (((row & 3u) << 2) | ((row >> 2) & 3u))); }
template <int OFF> __device__ __forceinline__ s16x4 tr_rd(unsigned addr) { s16x4 r; asm volatile("ds_read_b64_tr_b16 %0, %1 offset:%2" : "=&v"(r) : "v"(addr), "i"(OFF) : "memory"); return r; }
__device__ __forceinline__ float wave_scan_add(float v, int lane) {
#pragma unroll
    for (int o = 1; o < 64; o <<= 1) { const float t = lane_get(v, lane - o); if (lane >= o) v += t; }
    return v;
}
__device__ __forceinline__ float wave_scan_max(float v, int lane) {
#pragma unroll
    for (int o = 1; o < 64; o <<= 1) { const float t = lane_get(v, lane - o); if (lane >= o) v = fmaxf(v, t); }
    return v;
}
#define MFMA16(a, b, c) __builtin_amdgcn_mfma_f32_16x16x32_bf16(a, b, c, 0, 0, 0)
constexpr int ML_KT = 0, ML_VT = 32768, ML_ST = 65536, ML_CT = 98304, ML_AR = 135168;
template <int KS> __device__ __forceinline__ void mlstm_b_ks(LAS unsigned char* lds, f32x4 (&aI)[9], const unsigned (&tav)[8][2], unsigned rowoff, int w, const bf16x8& onesf, const bf16x8& Qf, float g) {
    {
        s16x4 vl[8], vh[8];
#pragma unroll
        for (int cc = 0; cc < 8; ++cc) { vl[cc] = tr_rd<8192 * KS>(tav[cc][0]); vh[cc] = tr_rd<8192 * KS>(tav[cc][1]); }
        const bf16x8 Sf = *(const LAS bf16x8*)(lds + ML_ST + 4096 * w + rowoff);
        LDS_WAIT(); __builtin_amdgcn_sched_barrier(0);
#pragma unroll
        for (int cc = 0; cc < 8; ++cc) { const bf16x8 Vf = (bf16x8){vl[cc][0], vl[cc][1], vl[cc][2], vl[cc][3], vh[cc][0], vh[cc][1], vh[cc][2], vh[cc][3]}; aI[cc] = MFMA16(Vf, Sf, aI[cc]); }
        aI[8] = MFMA16(onesf, Sf, aI[8]);
    }
    {
        bf16x8 Cf[9];
#pragma unroll
        for (int cc = 0; cc < 9; ++cc) Cf[cc] = *(const LAS bf16x8*)(lds + ML_CT + 4096 * cc + rowoff);
        u32x4 qw = *reinterpret_cast<const u32x4*>(&Qf);
        qw.x = cvt_pk_bf16(bf_lo(qw.x) * g, bf_hi(qw.x) * g); qw.y = cvt_pk_bf16(bf_lo(qw.y) * g, bf_hi(qw.y) * g); qw.z = cvt_pk_bf16(bf_lo(qw.z) * g, bf_hi(qw.z) * g); qw.w = cvt_pk_bf16(bf_lo(qw.w) * g, bf_hi(qw.w) * g);
        const bf16x8 Qg = *reinterpret_cast<const bf16x8*>(&qw);
        LDS_WAIT(); __builtin_amdgcn_sched_barrier(0);
#pragma unroll
        for (int cc = 0; cc < 9; ++cc) aI[cc] = MFMA16(Cf[cc], Qg, aI[cc]);
    }
}
template <int KS> __device__ __forceinline__ void mlstm_c_ks(LAS unsigned char* lds, f32x4 (&accC)[9], const unsigned (&tav)[8][2], unsigned tak0, unsigned tak1, const bf16x8& onesf, int fq) {
    s16x4 vl[8], vh[8];
    const s16x4 kl = tr_rd<8192 * KS>(tak0), kh = tr_rd<8192 * KS>(tak1);
#pragma unroll
    for (int cc = 0; cc < 8; ++cc) { vl[cc] = tr_rd<8192 * KS>(tav[cc][0]); vh[cc] = tr_rd<8192 * KS>(tav[cc][1]); }
    const LAS float* WK = (const LAS float*)(lds + ML_AR) + 640;
    const f32x4 wk0 = *(const LAS f32x4*)(WK + 32 * KS + 8 * fq), wk1 = *(const LAS f32x4*)(WK + 32 * KS + 8 * fq + 4);
    LDS_WAIT(); __builtin_amdgcn_sched_barrier(0);
    u32x4 kw;
    kw.x = cvt_pk_bf16(bf2f((unsigned short)kl[0]) * wk0[0], bf2f((unsigned short)kl[1]) * wk0[1]); kw.y = cvt_pk_bf16(bf2f((unsigned short)kl[2]) * wk0[2], bf2f((unsigned short)kl[3]) * wk0[3]);
    kw.z = cvt_pk_bf16(bf2f((unsigned short)kh[0]) * wk1[0], bf2f((unsigned short)kh[1]) * wk1[1]); kw.w = cvt_pk_bf16(bf2f((unsigned short)kh[2]) * wk1[2], bf2f((unsigned short)kh[3]) * wk1[3]);
    const bf16x8 Kf = *reinterpret_cast<bf16x8*>(&kw);
#pragma unroll
    for (int cc = 0; cc < 8; ++cc) { const bf16x8 Vf = (bf16x8){vl[cc][0], vl[cc][1], vl[cc][2], vl[cc][3], vh[cc][0], vh[cc][1], vh[cc][2], vh[cc][3]}; accC[cc] = MFMA16(Kf, Vf, accC[cc]); }
    accC[8] = MFMA16(Kf, onesf, accC[8]);
}
__device__ __forceinline__ void gld16(u32x4& r, const void* p) { asm volatile("global_load_dwordx4 %0, %1, off" : "=&v"(r) : "v"(p) : "memory"); }
__device__ __forceinline__ void gld4(float& r, const void* p) { asm volatile("global_load_dword %0, %1, off" : "=&v"(r) : "v"(p) : "memory"); }
__device__ __forceinline__ void mlstm_seq(Frame& F, const bf16_t* __restrict__ Z, const float* __restrict__ GATES, const float* __restrict__ gb, bf16_t* __restrict__ HOUT, int b, int h, int dir) {
    constexpr int KT = ML_KT, VT = ML_VT, ST = ML_ST, CT = ML_CT, AR = ML_AR;
    LAS unsigned char* lds = F.lds;
    const unsigned ldsb = (unsigned)(uintptr_t)lds;
    LAS float* LI = (LAS float*)(lds + AR); LAS float* LF = LI + 128; LAS float* CS = LI + 256; LAS float* MS = LI + 384; LAS float* BS = LI + 512; LAS float* WK = LI + 640; LAS float* SC = LI + 768;
    const int tid = F.tid, w = F.wave;
    const float bias_i = gb[dir * 8 + h], bias_f = gb[16 + dir * 8 + h];
    __syncthreads();
    { unsigned z_ = 0u; asm volatile("" : "+v"(z_)); for (int i = tid; i < 36864 / 16; i += 512) *(LAS u32x4*)(lds + CT + 16 * i) = (u32x4){z_, z_, z_, z_}; }
    f32x4 accC[9];
#pragma unroll
    for (int c = 0; c < 9; ++c) accC[c] = (f32x4){0.f, 0.f, 0.f, 0.f};
    float m_state = 0.f;
    const size_t tokb = (size_t)b * SEQ;
    u32x4 pk_[4], pv_[4], pq_[4]; float pli_ = 0.f, pfp_ = 0.f;
#define ML_PF_ISSUE(cn) do { const int l_ = hw_lane(), t_ = (w << 6) | l_; \
        if (t_ < 128) { const int pos = dir ? (SEQ - 1 - (128 * (cn) + t_)) : (128 * (cn) + t_); const float* gp = GATES + (tokb + pos) * 32; gld4(pli_, gp + dir * 8 + h); gld4(pfp_, gp + 16 + dir * 8 + h); } \
        _Pragma("unroll") for (int p = 0; p < 4; ++p) { const int idx = t_ + 512 * p, row = idx >> 4, ch = idx & 15; const int pos = dir ? (SEQ - 1 - (128 * (cn) + row)) : (128 * (cn) + row); \
            const bf16_t* src = Z + (tokb + pos) * LDZ + h * 128 + ch * 8; gld16(pk_[p], src + ZKM); gld16(pv_[p], src + ZVM); } \
        { const int row = 16 * w + (l_ & 15); const int pos = dir ? (SEQ - 1 - (128 * (cn) + row)) : (128 * (cn) + row); const bf16_t* src = Z + (tokb + pos) * LDZ + ZQM + h * 128 + 8 * (l_ >> 4); \
          _Pragma("unroll") for (int ks = 0; ks < 4; ++ks) gld16(pq_[ks], src + 32 * ks); } } while (0)
#define ML_PF_WAIT() asm volatile("s_waitcnt vmcnt(0)" : "+v"(pk_[0]), "+v"(pk_[1]), "+v"(pk_[2]), "+v"(pk_[3]), "+v"(pv_[0]), "+v"(pv_[1]), "+v"(pv_[2]), "+v"(pv_[3]), "+v"(pq_[0]), "+v"(pq_[1]), "+v"(pq_[2]), "+v"(pq_[3]), "+v"(pli_), "+v"(pfp_) : : "memory")
#pragma unroll
    for (int p = 0; p < 4; ++p) { pk_[p] = (u32x4){0u, 0u, 0u, 0u}; pv_[p] = pk_[p]; pq_[p] = pk_[p]; }
    ML_PF_ISSUE(0);
    for (int c = 0; c < 16; ++c) {
        const int lane = hw_lane();
        const int fr = lane & 15, fq = lane >> 4;
        unsigned rowoff[4];
#pragma unroll
        for (int s = 0; s < 4; ++s) rowoff[s] = 256u * fr + 64u * ((unsigned)s ^ (fr & 3u)) + 16u * ((unsigned)fq ^ ((fr >> 2) & 3u));
        unsigned trb[2], trx[2];
        { const unsigned q = fr >> 2, p = fr & 3;
#pragma unroll
          for (int t = 0; t < 2; ++t) { const unsigned x = (q << 2) | ((2u * fq + t) & 3u); trx[t] = x >> 1; trb[t] = ldsb + 256u * (8u * fq + 4u * t + q) + 16u * ((p >> 1) ^ (x & 1u)) + 8u * (p & 1u); } }
        unsigned tav[8][2];
#pragma unroll
        for (int cc = 0; cc < 8; ++cc)
#pragma unroll
            for (int t = 0; t < 2; ++t) tav[cc][t] = trb[t] + VT + 32u * ((unsigned)cc ^ trx[t]);
        const unsigned tak0 = trb[0] + KT + 32u * ((unsigned)w ^ trx[0]), tak1 = trb[1] + KT + 32u * ((unsigned)w ^ trx[1]);
        bf16x8 onesf;
#pragma unroll
        for (int i = 0; i < 8; ++i) onesf[i] = (fr == 0) ? (short)0x3F80 : (short)0;
        ML_PF_WAIT();
        if (tid < 128) { const float li = pli_ + bias_i, fp = pfp_ + bias_f;
            LI[tid] = li; LF[tid] = fminf(fp, 0.f) - __logf(1.0f + __expf(-fabsf(fp))); }
#pragma unroll
        for (int p = 0; p < 4; ++p) { const int idx = tid + 512 * p, row = idx >> 4, ch = idx & 15;
            *(LAS u32x4*)(lds + KT + offb(row, ch)) = pk_[p]; *(LAS u32x4*)(lds + VT + offb(row, ch)) = pv_[p]; }
        bf16x8 Qf[4];
#pragma unroll
        for (int ks = 0; ks < 4; ++ks) Qf[ks] = *reinterpret_cast<const bf16x8*>(&pq_[ks]);
        asm volatile("" ::: "memory");
        if (c + 1 < 16) ML_PF_ISSUE(c + 1);
        __syncthreads();
        if (w == 0) {
            const float x0 = LF[2 * lane], x1 = LF[2 * lane + 1], i0 = LI[2 * lane], i1 = LI[2 * lane + 1];
            const float s = x0 + x1, incl = wave_scan_add(s, lane), b0 = (incl - s) + x0, b1 = incl;
            const float c0 = i0 - b0, c1 = i1 - b1;
            const float im = wave_scan_max(fmaxf(c0, c1), lane); float em = lane_get(im, lane - 1); if (lane == 0) em = -3.0e38f;
            const float M0 = fmaxf(fmaxf(em, c0), m_state), M1 = fmaxf(im, m_state);
            const float Mlast = __int_as_float(__builtin_amdgcn_readlane(__float_as_int(M1), 63)), blast = __int_as_float(__builtin_amdgcn_readlane(__float_as_int(b1), 63));
            BS[2 * lane] = b0; BS[2 * lane + 1] = b1; CS[2 * lane] = c0; CS[2 * lane + 1] = c1; MS[2 * lane] = M0; MS[2 * lane + 1] = M1;
            WK[2 * lane] = __expf(c0 - Mlast); WK[2 * lane + 1] = __expf(c1 - Mlast);
            if (lane == 0) { SC[0] = blast; SC[1] = Mlast; }
        }
        __syncthreads();
        const float blast = SC[0], Mlast = SC[1];
        const float decay = __expf(m_state - Mlast);
        const float Mt = MS[16 * w + fr], bt = BS[16 * w + fr];
#pragma unroll
        for (int j = 0; j < 8; ++j) {
            u32x2 pk = (u32x2){0u, 0u};
            if (j <= w) {
                f32x4 a = (f32x4){0.f, 0.f, 0.f, 0.f};
#pragma unroll
                for (int ks = 0; ks < 4; ++ks) { const bf16x8 Af = *(const LAS bf16x8*)(lds + KT + 4096 * j + rowoff[ks]); a = MFMA16(Af, Qf[ks], a); }
                const f32x4 cs = *(const LAS f32x4*)(CS + 16 * j + 4 * fq);
                float v[4];
#pragma unroll
                for (int r = 0; r < 4; ++r) { const int s = 16 * j + 4 * fq + r, t = 16 * w + fr; v[r] = (s <= t) ? a[r] * __expf(cs[r] - Mt) : 0.f; }
                pk.x = cvt_pk_bf16(v[0], v[1]); pk.y = cvt_pk_bf16(v[2], v[3]);
            }
            *(LAS u32x2*)(lds + ST + offb(16 * w + fr, 2 * j + (fq >> 1)) + 8 * (fq & 1)) = pk;
        }
        LDS_WAIT();
        const float g = __expf(m_state - Mt);
        f32x4 aI[9];
#pragma unroll
        for (int cc = 0; cc < 9; ++cc) aI[cc] = (f32x4){0.f, 0.f, 0.f, 0.f};
        mlstm_b_ks<0>(lds, aI, tav, rowoff[0], w, onesf, Qf[0], g); mlstm_b_ks<1>(lds, aI, tav, rowoff[1], w, onesf, Qf[1], g);
        mlstm_b_ks<2>(lds, aI, tav, rowoff[2], w, onesf, Qf[2], g); mlstm_b_ks<3>(lds, aI, tav, rowoff[3], w, onesf, Qf[3], g);
        {
            const float den = lane_get(aI[8][0], fr);
            const float inv = 1.0f / fmaxf(fabsf(den), __expf(-(bt + Mt)));
            const int row = 16 * w + fr; const int pos = dir ? (SEQ - 1 - (128 * c + row)) : (128 * c + row);
            bf16_t* op = HOUT + (tokb + pos) * 1024 + h * 128 + 16 * (fq & 1) + 8 * (fq >> 1);
#pragma unroll
            for (int cp = 0; cp < 4; ++cp) { const f32x4 h0 = aI[2 * cp] * inv, h1 = aI[2 * cp + 1] * inv;
                const unsigned a0 = cvt_pk_bf16(h0[0], h0[1]), a1 = cvt_pk_bf16(h0[2], h0[3]), b0 = cvt_pk_bf16(h1[0], h1[1]), b1 = cvt_pk_bf16(h1[2], h1[3]);
                const auto r0 = __builtin_amdgcn_permlane16_swap(a0, b0, false, false); const auto r1 = __builtin_amdgcn_permlane16_swap(a1, b1, false, false);
                *(u32x4*)(op + 32 * cp) = (u32x4){r0[0], r1[0], r0[1], r1[1]}; }
        }
#pragma unroll
        for (int cc = 0; cc < 9; ++cc) accC[cc] = accC[cc] * decay;
        mlstm_c_ks<0>(lds, accC, tav, tak0, tak1, onesf, fq); mlstm_c_ks<1>(lds, accC, tav, tak0, tak1, onesf, fq);
        mlstm_c_ks<2>(lds, accC, tav, tak0, tak1, onesf, fq); mlstm_c_ks<3>(lds, accC, tav, tak0, tak1, onesf, fq);
        m_state = blast + Mlast;
        __syncthreads();
        float one_ = 1.0f; asm volatile("" : "+v"(one_));
#pragma unroll
        for (int cc = 0; cc < 9; ++cc) { const f32x4 ct = accC[cc] * one_; u32x2 o; o.x = cvt_pk_bf16(ct[0], ct[1]); o.y = cvt_pk_bf16(ct[2], ct[3]);
            *(LAS u32x2*)(lds + CT + offb(16 * cc + fr, 2 * w + (fq >> 1)) + 8 * (fq & 1)) = o; }
    }
    __syncthreads();
}

__device__ __forceinline__ void router_phase(Frame& F, const unsigned char* HB, const float* part, const float* rin, float* listf, const unsigned char* WR, const float* b_rg, const float* b_re, unsigned* gcnt, int* LIST, int* TOKE, int* TOKP, float* TOKW) {
    const int tid = F.tid, lane = F.lane, w = F.wave, fr = lane & 15, fq = lane >> 4;
    volatile LAS unsigned* LCNT = F.MISC + 96; volatile LAS unsigned* LBASE = F.MISC + 128;
    LAS float* LG = (LAS float*)(F.lds + w * 3072);
    for (int blk = F.vcu; blk < T_TOK / 128; blk += F.G) {
        const int r0 = blk * 128 + 16 * w;
        f32x4 acc[3];
        skinny16_i8<3>(HB, DM, WR, DM, r0, fr, fq, 1.0f / (QA2 * QW_2048), acc);
        float f_;
        { float ps = 0.f;
#pragma unroll
          for (int j = 0; j < 8; ++j) ps += part[(size_t)(fq * 8 + j) * T_TOK + r0 + fr];
          ps += xor_shfl<16>(ps);
          { auto rr = __builtin_amdgcn_permlane32_swap(__float_as_uint(ps), __float_as_uint(ps), false, false); ps = __uint_as_float(rr[0]) + __uint_as_float(rr[1]); }
          f_ = (1.0f / sqrtf(ps * (1.f / DM) + EPS)) / rin[r0 + fr];
        }
#pragma unroll
        for (int n = 0; n < 3; ++n)
#pragma unroll
            for (int r = 0; r < 4; ++r) LG[(4 * fq + r) * 48 + 16 * n + fr] = acc[n][r];
        if (tid < 32) LCNT[tid] = 0u;
        LDS_WAIT();
        __syncthreads();
        int e0 = 0, e1 = 0; float w0 = 0.f, w1 = 0.f; unsigned pl0 = 0, pl1 = 0;
        if (lane < 16) {
            const LAS float* lg = LG + lane * 48;
            float gl[4]; int gi = 0; float gm = -3.0e38f;
#pragma unroll
            for (int j = 0; j < 4; ++j) { gl[j] = lg[j] * f_ + b_rg[j]; if (gl[j] > gm) { gm = gl[j]; gi = j; } }
            float gs = 0.f;
#pragma unroll
            for (int j = 0; j < 4; ++j) gs += __expf(gl[j] - gm);
            const float gp = 1.0f / gs;
            float v0 = -3.0e38f, v1 = -3.0e38f; int j0 = 0, j1 = 0;
            for (int j = 0; j < 8; ++j) { const float v = lg[4 + 8 * gi + j] * f_ + b_re[8 * gi + j];
                if (v > v0) { v1 = v0; j1 = j0; v0 = v; j0 = j; } else if (v > v1) { v1 = v; j1 = j; } }
            const float x = __expf(v1 - v0);
            w0 = gp / (1.0f + x); w1 = gp * x / (1.0f + x);
            e0 = gi * 8 + j0; e1 = gi * 8 + j1;
            pl0 = __hip_atomic_fetch_add((LAS unsigned*)(LCNT + e0), 1u, __ATOMIC_RELAXED, __HIP_MEMORY_SCOPE_WORKGROUP);
            pl1 = __hip_atomic_fetch_add((LAS unsigned*)(LCNT + e1), 1u, __ATOMIC_RELAXED, __HIP_MEMORY_SCOPE_WORKGROUP);
        }
        __syncthreads();
        if (tid < 32) { const unsigned n = LCNT[tid]; LBASE[tid] = n ? __hip_atomic_fetch_add(gcnt + tid, n, RLX_AGENT) : 0u; }
        __syncthreads();
        if (lane < 16) {
            const int tok = r0 + lane; const int p0 = (int)(LBASE[e0] + pl0), p1 = (int)(LBASE[e1] + pl1);
            __hip_atomic_store(LIST + (size_t)e0 * LISTCAP + p0, tok, RLX_AGENT); __hip_atomic_store(LIST + (size_t)e1 * LISTCAP + p1, tok, RLX_AGENT);
            listf[(size_t)e0 * LISTCAP + p0] = f_; listf[(size_t)e1 * LISTCAP + p1] = f_;
            TOKE[2 * tok] = e0; TOKE[2 * tok + 1] = e1; TOKP[2 * tok] = p0; TOKP[2 * tok + 1] = p1; TOKW[2 * tok] = w0; TOKW[2 * tok + 1] = w1;
        }
        __syncthreads();
    }
}
__device__ __forceinline__ void moe_table(Frame& F, const unsigned* gcnt) {
    volatile LAS int* MCNT = (volatile LAS int*)(F.MISC + 16); volatile LAS int* MCUM = (volatile LAS int*)(F.MISC + 48);
    __syncthreads();
    if (F.tid < 32) MCNT[F.tid] = (int)__hip_atomic_load(gcnt + F.tid, RLX_AGENT);
    __syncthreads();
    if (F.tid == 0) { int s = 0; for (int e = 0; e < NEXP; ++e) { MCUM[e] = s; s += (MCNT[e] + 255) >> 8; } MCUM[NEXP] = s; }
    __syncthreads();
}

struct Args { const float* in[23]; float* out; unsigned char* ws; int ph_lo, ph_hi; };
constexpr int PH_PER_LAYER = 12, N_PHASES = DEPTH * PH_PER_LAYER + 1;

__global__ void __launch_bounds__(NWAVES * 64, 2) fwd_kernel(Args args) {
    extern __shared__ __attribute__((aligned(16))) unsigned char lds[];
    Frame F;
    F.lds = (LAS unsigned char*)lds; F.ldsg = lds;
    F.MISC = (volatile LAS unsigned*)(F.lds + MISC_OFF);
    F.tid = threadIdx.x; F.lane = F.tid & 63; F.wave = __builtin_amdgcn_readfirstlane(F.tid >> 6);
    F.G = gridDim.x; { const int bx = blockIdx.x; F.vcu = (bx % 8) * (F.G / 8) + bx / 8; }
    unsigned char* ws = args.ws;
    F.ctl = (unsigned*)(ws + WS_CTL);
    for (int u = F.tid; u < 256; u += NWAVES * 64) F.MISC[u] = 0u;
    __syncthreads();
#if MK_PER_PHASE
    XcdBarrier bar; bar.bar = F.ctl + CW_BAR; bar.x = 0; bar.st = nullptr;
#define GRID_BAR() do { } while (0)
#else
    XcdBarrier bar = xcd_barrier_post(F.ctl + CW_BAR, F.MISC + 0);
#define GRID_BAR() xcd_barrier(bar)
#endif
    const int lo = args.ph_lo, hi = args.ph_hi; (void)lo; (void)hi;
#if MK_PER_PHASE
#define IN(k) (lo <= (k) && (k) < hi)
#else
#define IN(k) true
#endif
#define SEAM(k) do { if (IN((k) + 1)) GRID_BAR(); } while (0)
#define PHASE_BEGIN() do { const int t_ = hw_tid(wave0); F.tid = t_; F.lane = t_ & 63; F.wave = __builtin_amdgcn_readfirstlane(t_ >> 6); \
        int b_ = blockIdx.x; asm volatile("" : "+s"(b_)); bx = b_; F.vcu = (b_ % 8) * (G / 8) + b_ / 8; gw = F.vcu * NWAVES + F.wave; \
        unsigned lb_ = 0; asm volatile("" : "+s"(lb_)); F.ldsg = lds + lb_; F.lds = (LAS unsigned char*)lds + lb_; F.MISC = (volatile LAS unsigned*)(F.lds + MISC_OFF); \
        F.ctl = (unsigned*)(args.ws + opq_off(WS_CTL)); ws = args.ws + opq_off(0); } while (0)
#define INP(i) (args.in[opq_idx(i)])
#define Z_ ((bf16_t*)(args.ws + opq_off(WS_Z)))
#define HB_ ((bf16_t*)(args.ws + opq_off(WS_HB)))
#define HFW_ ((bf16_t*)(args.ws + opq_off(WS_HFW)))
#define HBW_ ((bf16_t*)(args.ws + opq_off(WS_HBW)))
#define HID_ ((bf16_t*)(args.ws + opq_off(WS_HID)))
#define YS_ ((bf16_t*)(args.ws + opq_off(WS_YS)))
#define PP_ ((bf16_t*)(args.ws + opq_off(WS_PP)))
#define PB_ ((bf16_t*)(args.ws + opq_off(WS_PB)))
#define GATES_ ((float*)(args.ws + opq_off(WS_GATES)))
#define TOKE_ ((int*)(args.ws + opq_off(WS_TOKE)))
#define TOKP_ ((int*)(args.ws + opq_off(WS_TOKP)))
#define TOKW_ ((float*)(args.ws + opq_off(WS_TOKW)))
#define LIST_ ((int*)(args.ws + opq_off(WS_LIST)))
#define X_ (args.out)
#define XB_ ((bf16_t*)args.out)
#define XF_ ((bf16_t*)(args.ws + opq_off(WS_XF)))
    const int G = F.G, NGW = G * NWAVES; int bx = (int)blockIdx.x, gw = F.vcu * NWAVES + F.wave; const int wave0 = F.wave;

    for (int layer = 0; layer < DEPTH; ++layer) {
        const int P = layer * PH_PER_LAYER;

        if (IN(P + 0)) {
            PHASE_BEGIN();
            LayerW L;
            L.w_in = INP(3) + (size_t)layer * DM * INW; L.w_bm = INP(8) + (size_t)layer * 1024 * DM; L.w_ba = INP(9) + (size_t)layer * 1024 * DM; L.w_out = INP(10) + (size_t)layer * DM * DM;
            L.w_rg = INP(12) + (size_t)layer * DM * 4; L.w_re = INP(14) + (size_t)layer * DM * 32;
            L.w_eg = INP(16) + (size_t)layer * NEXP * DM * DFF; L.w_eu = INP(17) + (size_t)layer * NEXP * DM * DFF; L.w_ed = INP(18) + (size_t)layer * NEXP * DFF * DM;
            L.w_pg = INP(20) + (size_t)layer * DM * DM; L.w_pp = INP(21) + (size_t)layer * PLE * DM; L.p = INP(1) + (size_t)layer * T_TOK * PLE;
            if (layer == 0) convert_weights<0>(F, L, args.ws);
            const float* g1 = INP(2) + layer * DM;
            if (layer == 0) norm_pass<false>(INP(0), nullptr, args.ws + opq_off(WS_HB8), g1, gw, NGW, F.lane, (float*)(args.ws + opq_off(WS_RIN)));
            else norm_pass_b16w(XB_, args.ws + opq_off(WS_HB8), g1, gw, NGW, F.lane, (float*)(args.ws + opq_off(WS_RIN)));
            SEAM(P + 0);
        }
        if (IN(P + 1)) {
            PHASE_BEGIN();
            { const int fr = F.lane & 15, fq = F.lane >> 4;
              for (int task = gw; task < T_TOK / 16; task += NGW) { f32x4 acc[2]; skinny16_i8<2>(args.ws + opq_off(WS_HB8), DM, args.ws + opq_off(WS_WG), DM, task * 16, fr, fq, 1.0f / (QA * QW_2048), acc);
#pragma unroll
                  for (int n = 0; n < 2; ++n)
#pragma unroll
                      for (int r = 0; r < 4; ++r) GATES_[(size_t)(task * 16 + 4 * fq + r) * 32 + 16 * n + fr] = acc[n][r]; } }
            pg8::DenseSched S; S.init(args.ws + opq_off(WS_HB8), DM / 2, args.ws + opq_off(WS_WIN), DM / 2, T_TOK, LDZ, G, bx);
            pg8::EpiZ E{Z_, 1.0f / (QA * QW_2048)};
            pg8::gemm_phase<pg8::EpiZ, pg8::DenseSched, true>(F.lds, DM / 2, S, E, F.wave);
            SEAM(P + 1);
        }
        if (IN(P + 2)) {
            PHASE_BEGIN();
            qk_prepass(F, Z_, INP(7) + layer * 128);
            for (int seq = F.vcu; seq < 256; seq += G) { const int b = seq >> 4, h = (seq >> 1) & 7, dir = seq & 1;
                mlstm_seq(F, Z_, GATES_, INP(4) + layer * 32, dir ? HBW_ : HFW_, b, h, dir); }
            SEAM(P + 2);
        }
        if (IN(P + 3)) {
            PHASE_BEGIN();
            if (F.tid < 128) ((LAS float*)(F.lds + GQ_OFF))[F.tid] = (INP(6) + layer * 128)[F.tid];
            __syncthreads();
            const int x8 = bx & 7, j = bx >> 3, per = G >> 3;
            const int cslot = j % 5; bool cdone = false;
#define P3_CONVERT() do { PHASE_BEGIN(); LayerW L;     \
                L.w_in = INP(3) + (size_t)layer * DM * INW; L.w_bm = INP(8) + (size_t)layer * 1024 * DM; L.w_ba = INP(9) + (size_t)layer * 1024 * DM; L.w_out = INP(10) + (size_t)layer * DM * DM; \
                L.w_rg = INP(12) + (size_t)layer * DM * 4; L.w_re = INP(14) + (size_t)layer * DM * 32; \
                L.w_eg = INP(16) + (size_t)layer * NEXP * DM * DFF; L.w_eu = INP(17) + (size_t)layer * NEXP * DM * DFF; L.w_ed = INP(18) + (size_t)layer * NEXP * DFF * DM; \
                L.w_pg = INP(20) + (size_t)layer * DM * DM; L.w_pp = INP(21) + (size_t)layer * PLE * DM; L.p = INP(1) + (size_t)layer * T_TOK * PLE; \
                ym_combine(F, Z_, HFW_, HBW_, INP(5) + layer * 1024); __syncthreads(); \
                convert_weights<1>(F, L, args.ws); \
                if (layer + 1 < DEPTH) { L.w_in = INP(3) + (size_t)(layer + 1) * DM * INW; convert_weights<0>(F, L, args.ws); } } while (0)
            for (int i = 0; ; ++i) {
                if (i == cslot) { P3_CONVERT(); cdone = true; __syncthreads(); }
                int unit;
                if ((G & 7) == 0) { const int jj = i * per + j; if (jj >= 128) break; unit = x8 * 128 + jj; } else { unit = i * G + bx; if (unit >= 1024) break; }
                const int qb = unit & 7, hh = (unit >> 3) & 7, b = unit >> 6, kvh = hh >> 2;
                const size_t rowq = (size_t)b * SEQ + qb * 256;
                const int tu_ = hw_tid(F.wave);
                att::attn_dense_body(Z_ + rowq * LDZ + ZQA + hh * 128, Z_ + (size_t)b * SEQ * LDZ + ZKA + kvh * 128, Z_ + (size_t)b * SEQ * LDZ + ZVA + kvh * 128, args.ws + opq_off(WS_YA8) + rowq * 1024 + hh * 128, SEQ, (char*)F.ldsg, tu_, (const LAS float*)(F.lds + GQ_OFF), qb * 256);
            }
            if (!cdone) { __syncthreads(); P3_CONVERT(); }
#undef P3_CONVERT
            SEAM(P + 3);
        }
        if (IN(P + 4)) {
            PHASE_BEGIN();
            { pg8::DenseSched S; S.init(Z_ + ZQM, LDZ, args.ws + opq_off(WS_WBM), 512, T_TOK, DM, G, bx); pg8::EpiMerge<false> E{Z_, (unsigned char*)HB_, nullptr, 1.0f / (QA * QW_1024 * 255.0f)}; pg8::gemm_phase<pg8::EpiMerge<false>, pg8::DenseSched, true>(F.lds, 512, S, E, F.wave); }
            { pg8::DenseSched S; S.init(args.ws + opq_off(WS_YA8), 512, args.ws + opq_off(WS_WBA), 512, T_TOK, DM, G, bx); pg8::EpiMerge<true> E{Z_, (unsigned char*)HB_, args.ws + opq_off(WS_HB8), 1.0f / (QYA * QW_1024 * 255.0f)}; pg8::gemm_phase<pg8::EpiMerge<true>, pg8::DenseSched, true>(F.lds, 512, S, E, F.wave); }
            SEAM(P + 4);
        }
        if (IN(P + 5)) {
            PHASE_BEGIN();
            pg8::DenseSched S; S.init(args.ws + opq_off(WS_HB8), DM / 2, args.ws + opq_off(WS_WOUT), DM / 2, T_TOK, DM, G, bx); pg8::EpiResidQ E{layer == 0 ? INP(0) : nullptr, XB_, XB_, (unsigned char*)HFW_, INP(11) + layer * DM, (const float*)(args.ws + opq_off(WS_RIN)), (float*)(args.ws + opq_off(WS_PART)), 1.0f / (QM * QW_2048)};
            pg8::gemm_phase<pg8::EpiResidQ, pg8::DenseSched, true>(F.lds, DM / 2, S, E, F.wave);
            SEAM(P + 5);
        }
        if (IN(P + 7)) {
            PHASE_BEGIN();
            router_phase(F, (const unsigned char*)HFW_, (const float*)(args.ws + opq_off(WS_PART)), (const float*)(args.ws + opq_off(WS_RIN)), (float*)(args.ws + opq_off(WS_LISTF)), args.ws + opq_off(WS_WR), INP(13) + layer * 4, INP(15) + layer * 32, (F.ctl + CW_CNT + 64 * layer), LIST_, TOKE_, TOKP_, TOKW_);
            SEAM(P + 7);
        }
        if (IN(P + 8)) {
            PHASE_BEGIN();
            moe_table(F, (F.ctl + CW_CNT + 64 * layer));
            pg8::MoeUpSched S; S.A = (const char*)HFW_; S.Bt = (const char*)(args.ws + opq_off(WS_WGU)); S.ldaB = DM; S.ldbB = DM; S.list = LIST_;
            S.mcnt = (const volatile LAS int*)(F.MISC + 16); S.mcum = (const volatile LAS int*)(F.MISC + 48); S.nwg = S.mcum[NEXP] * 4; S.G = G; S.c = bx;
            pg8::EpiSwiGLU E{(unsigned char*)HID_, (const float*)(args.ws + opq_off(WS_LISTF)), (const volatile LAS int*)(F.MISC + 16), 1.0f / (QA2 * QW_2048)};
            pg8::gemm_phase<pg8::EpiSwiGLU, pg8::MoeUpSched, true>(F.lds, DM / 2, S, E, F.wave);
            SEAM(P + 8);
        }
        if (IN(P + 9)) {
            PHASE_BEGIN();
#if MK_PER_PHASE
            moe_table(F, (F.ctl + CW_CNT + 64 * layer));
#endif
            pg8::MoeDownSched S; S.A = (const char*)HID_; S.Bt = (const char*)(args.ws + opq_off(WS_WD)); S.ldaB = DFF; S.ldbB = DFF;
            S.mcum = (const volatile LAS int*)(F.MISC + 48); S.nwg = S.mcum[NEXP] * 8; S.G = G; S.c = bx;
            pg8::EpiI8 E{(unsigned char*)YS_, DM, QY / (QH * QW_512)};
            pg8::gemm_phase<pg8::EpiI8, pg8::MoeDownSched, true>(F.lds, opq_idx(DFF / 2), S, E, F.wave);
            SEAM(P + 9);
        }
        if (IN(P + 10)) {
            PHASE_BEGIN();
#if MK_PER_PHASE
            moe_table(F, (F.ctl + CW_CNT + 64 * layer));
#endif
            { const volatile LAS int* MCUM = (const volatile LAS int*)(F.MISC + 48); const float* gpl = INP(19) + layer * DM; const int lane = F.lane;
              const int* te = TOKE_; const int* tp = TOKP_; const float* tw = TOKW_; const unsigned char* ys = (const unsigned char*)YS_; unsigned char* hb8 = args.ws + opq_off(WS_HB8);
              f32x4 gv[8];
#pragma unroll
              for (int jj = 0; jj < 2; ++jj)
#pragma unroll
                  for (int q = 0; q < 4; ++q) gv[4 * jj + q] = ((const f32x4*)gpl)[4 * (lane + 64 * jj) + q];
              int m = gw; int ne0 = 0, ne1 = 0, np0 = 0, np1 = 0; float nw0 = 0.f, nw1 = 0.f;
              if (m < T_TOK) { ne0 = te[2 * m]; ne1 = te[2 * m + 1]; np0 = tp[2 * m]; np1 = tp[2 * m + 1]; nw0 = tw[2 * m]; nw1 = tw[2 * m + 1]; }
              for (; m < T_TOK; m += NGW) {
                  const size_t s0 = (size_t)MCUM[ne0] * 256 + np0, s1 = (size_t)MCUM[ne1] * 256 + np1;
                  const float w0 = nw0 * (1.0f / QY), w1 = nw1 * (1.0f / QY);
                  { const int mn = m + NGW; if (mn < T_TOK) { ne0 = te[2 * mn]; ne1 = te[2 * mn + 1]; np0 = tp[2 * mn]; np1 = tp[2 * mn + 1]; nw0 = tw[2 * mn]; nw1 = tw[2 * mn + 1]; } }
                  u32x4* xr = (u32x4*)(XB_ + (size_t)m * DM) + 2 * lane; const u32x4* y0 = (const u32x4*)(ys + s0 * DM) + lane; const u32x4* y1 = (const u32x4*)(ys + s1 * DM) + lane;
                  f32x4 v[8]; float s = 0.f;
#pragma unroll
                  for (int jj = 0; jj < 2; ++jj) { const u32x4 aw = y0[64 * jj], bw = y1[64 * jj]; const u32x4 xa = xr[128 * jj], xb = xr[128 * jj + 1]; f32x4 t[4]; pg8::unpack8(xa, t[0], t[1]); pg8::unpack8(xb, t[2], t[3]);
#pragma unroll
                      for (int q = 0; q < 4; ++q) { t[q] = t[q] + s8x4_f(aw[q]) * w0 + s8x4_f(bw[q]) * w1; v[4 * jj + q] = t[q];
                          s += (t[q].x * t[q].x + t[q].y * t[q].y) + (t[q].z * t[q].z + t[q].w * t[q].w); }
                      xr[128 * jj] = pg8::pack8(t[0], t[1]); xr[128 * jj + 1] = pg8::pack8(t[2], t[3]); }
                  const float rstd = 1.0f / sqrtf(wave_sum(s) * (1.f / DM) + EPS);
                  u32x4* q8p = (u32x4*)(hb8 + (size_t)m * DM) + lane;
#pragma unroll
                  for (int jj = 0; jj < 2; ++jj) { u32x4 q_;
#pragma unroll
                      for (int q = 0; q < 4; ++q) q_[q] = q8x4(v[4 * jj + q] * rstd * gv[4 * jj + q], QA);
                      q8p[64 * jj] = q_; }
              } }
            __syncthreads();
            pg8::DenseSched S; S.init(PB_, PLE, args.ws + opq_off(WS_WPP), PLE, T_TOK, DM, G, bx); pg8::EpiI8 E{(unsigned char*)PP_, DM, QP};
            pg8::gemm_phase<pg8::EpiI8, pg8::DenseSched>(F.lds, PLE, S, E, F.wave);
            SEAM(P + 10);
        }
        if (IN(P + 11)) {
            PHASE_BEGIN();
            pg8::DenseSched S; S.init(args.ws + opq_off(WS_HB8), DM / 2, args.ws + opq_off(WS_WPG), DM / 2, T_TOK, DM, G, bx); pg8::EpiPle E{XB_, layer == DEPTH - 1 ? XF_ : XB_, (const unsigned char*)PP_, 1.0f / (QA * QW_2048)};
            pg8::gemm_phase<pg8::EpiPle, pg8::DenseSched, true>(F.lds, DM / 2, S, E, F.wave);
            SEAM(P + 11);
        }
    }
    if (IN(DEPTH * PH_PER_LAYER)) {
        PHASE_BEGIN();
        norm_pass_b16<true>(XF_, X_, nullptr, INP(22), gw, NGW, F.lane);
    }
#undef IN
#undef SEAM
}

extern "C" void kernel_launch(void* const* d_in, const int* in_sizes, int n_in, void* d_out, int out_size, void* d_ws, size_t ws_size, hipStream_t stream) {
    static int grid = 0;
    if (grid == 0) {
        if (n_in != 23 || in_sizes[0] != T_TOK * DM || out_size != T_TOK * DM || ws_size < WS_END2) {
            fprintf(stderr, "kernel_launch: shape/workspace mismatch: n_in %d in0 %d out %d ws %zu (need %zu)\n", n_in, n_in > 0 ? in_sizes[0] : -1, out_size, ws_size, (size_t)WS_END2); grid = -1; return; }
        int dev = 0, cus = 0, per_cu = 0;
        if (hipGetDevice(&dev) != hipSuccess || hipDeviceGetAttribute(&cus, hipDeviceAttributeMultiprocessorCount, dev) != hipSuccess) { grid = -1; return; }
        if (hipFuncSetAttribute((const void*)fwd_kernel, hipFuncAttributeMaxDynamicSharedMemorySize, LDS_BYTES) != hipSuccess) { fprintf(stderr, "kernel_launch: hipFuncSetAttribute failed\n"); grid = -1; return; }
        if (hipOccupancyMaxActiveBlocksPerMultiprocessor(&per_cu, (const void*)fwd_kernel, NWAVES * 64, LDS_BYTES) != hipSuccess || per_cu < 1) fprintf(stderr, "kernel_launch: occupancy query reports %d\n", per_cu);
        (void)hipGetLastError();
        grid = cus - (cus % 8);
    }
    if (grid < 0) return;
    if (hipMemsetAsync((char*)d_ws + WS_CTL, 0, CTL_ZERO_BYTES, stream) != hipSuccess) return;
    Args a{};
    for (int i = 0; i < 23; ++i) a.in[i] = (const float*)d_in[i];
    a.out = (float*)d_out; a.ws = (unsigned char*)d_ws;
#if MK_PER_PHASE
    for (int p = 0; p < N_PHASES; ++p) { a.ph_lo = p; a.ph_hi = p + 1; hipLaunchKernelGGL(fwd_kernel, dim3(grid), dim3(NWAVES * 64), LDS_BYTES, stream, a); }
#else
    a.ph_lo = 0; a.ph_hi = N_PHASES;
    hipLaunchKernelGGL(fwd_kernel, dim3(grid), dim3(NWAVES * 64), LDS_BYTES, stream, a);
#endif
    const hipError_t le = hipPeekAtLastError();
    if (le != hipSuccess) fprintf(stderr, "kernel_launch: launch failed: %s\n", hipGetErrorName(le));
}
```
